# Optimizing an MI355X kernel written in HIP

```python
import jax, jax.numpy as jnp
from jax import lax
import numpy as np

D_MODEL = 2048
BATCH = 2
SEQ = 8192
DEPTH = 2

RMS_EPS = 1e-6
ROPE_THETA = 10000.0
D_FF = 5632
Q_BLOCK = 128

MLA_HEADS = 8
MLA_Q_LORA = 512
MLA_KV_LORA = 256
MLA_NOPE_DIM = 128
MLA_ROPE_DIM = 64
MLA_V_DIM = 128

SWA_HEADS = 8
SWA_KV_HEADS = 2
SWA_HEAD_DIM = 64
WINDOW = 128

FOX_HEADS = 8
FOX_HEAD_DIM = 64

IN_SPLITS = [
    MLA_Q_LORA,
    MLA_KV_LORA,
    MLA_ROPE_DIM,
    SWA_HEADS * SWA_HEAD_DIM,
    SWA_KV_HEADS * SWA_HEAD_DIM,
    SWA_KV_HEADS * SWA_HEAD_DIM,
    FOX_HEADS * FOX_HEAD_DIM,
    FOX_HEADS * FOX_HEAD_DIM,
    FOX_HEADS * FOX_HEAD_DIM,
    FOX_HEADS,
]
IN_COLS = int(sum(IN_SPLITS))
IN_OFFSETS = [int(o) for o in np.cumsum(IN_SPLITS)[:-1]]
MIX_WIDTH = MLA_HEADS * MLA_V_DIM + SWA_HEADS * SWA_HEAD_DIM + FOX_HEADS * FOX_HEAD_DIM

kernel_name = "hybrid_mla_swa_sink_fox_macaron"


def rmsnorm(x, g):
    x32 = x.astype(jnp.float32)
    y = x32 * lax.rsqrt(jnp.mean(x32 * x32, axis=-1, keepdims=True) + RMS_EPS)
    return (y * g.astype(jnp.float32)).astype(x.dtype)


def swiglu(h, w_gate, w_up, w_down):
    return (jax.nn.silu(h @ w_gate) * (h @ w_up)) @ w_down


def rope_tables(positions, dim):
    inv_freq = ROPE_THETA ** (-jnp.arange(0, dim, 2, dtype=jnp.float32) / dim)
    ang = positions.astype(jnp.float32)[..., None] * inv_freq
    return jnp.cos(ang), jnp.sin(ang)


def apply_rope(x, cos, sin):
    half = x.shape[-1] // 2
    x1, x2 = x[..., :half], x[..., half:]
    c, s = cos[:, :, None, :], sin[:, :, None, :]
    return jnp.concatenate([x1 * c - x2 * s, x2 * c + x1 * s], axis=-1).astype(x.dtype)


def causal_block_attention(q, k, v, scale, log_f_cum=None):
    B, S, H, dq = q.shape
    dv = v.shape[-1]
    n = S // Q_BLOCK
    qb = q.reshape(B, n, Q_BLOCK, H, dq).transpose(1, 0, 2, 3, 4)
    key_pos = jnp.arange(S)
    idx = jnp.arange(n)

    def scores_for(i, qi):
        s = jnp.einsum('bqhd,bkhd->bhqk', qi, k).astype(jnp.float32) * scale
        q_pos = i * Q_BLOCK + jnp.arange(Q_BLOCK)
        return s, key_pos[None, :] <= q_pos[:, None]

    def finish(s, mask):
        s = jnp.where(mask[None, None], s, -jnp.inf)
        p = jax.nn.softmax(s, axis=-1).astype(v.dtype)
        return jnp.einsum('bhqk,bkhd->bqhd', p, v)

    if log_f_cum is None:
        def step(args):
            i, qi = args
            s, mask = scores_for(i, qi)
            return finish(s, mask)
        out = lax.map(step, (idx, qb))
    else:
        c_all = log_f_cum.transpose(0, 2, 1)
        cb = log_f_cum.reshape(B, n, Q_BLOCK, H).transpose(1, 0, 3, 2)

        def step(args):
            i, qi, ci = args
            s, mask = scores_for(i, qi)
            s = s + (ci[..., :, None] - c_all[:, :, None, :])
            return finish(s, mask)
        out = lax.map(step, (idx, qb, cb))
    return out.transpose(1, 0, 2, 3, 4).reshape(B, S, H, dv)


def sliding_window_sink_attention(q, k, v, sinks):
    B, S, H, d = q.shape
    Hkv = k.shape[2]
    G = H // Hkv
    n = S // WINDOW
    qb = q.reshape(B, n, WINDOW, Hkv, G, d)
    pad = jnp.zeros((B, WINDOW, Hkv, d), k.dtype)
    kp = jnp.concatenate([pad, k], axis=1).reshape(B, n + 1, WINDOW, Hkv, d)
    vp = jnp.concatenate([pad.astype(v.dtype), v], axis=1).reshape(B, n + 1, WINDOW, Hkv, d)
    kw = jnp.concatenate([kp[:, :-1], kp[:, 1:]], axis=2)
    vw = jnp.concatenate([vp[:, :-1], vp[:, 1:]], axis=2)
    s = jnp.einsum('bnqhgd,bnkhd->bnhgqk', qb, kw).astype(jnp.float32) * (d ** -0.5)
    blk = jnp.arange(n)[:, None, None]
    q_pos = blk * WINDOW + jnp.arange(WINDOW)[None, :, None]
    k_pos = (blk - 1) * WINDOW + jnp.arange(2 * WINDOW)[None, None, :]
    mask = (k_pos <= q_pos) & (k_pos > q_pos - WINDOW) & (k_pos >= 0)
    s = jnp.where(mask[None, :, None, None], s, -jnp.inf)
    sink = jnp.broadcast_to(sinks.astype(jnp.float32).reshape(Hkv, G)[None, None, :, :, None, None],
                            s.shape[:-1] + (1,))
    p = jax.nn.softmax(jnp.concatenate([s, sink], axis=-1), axis=-1)[..., :-1]
    o = jnp.einsum('bnhgqk,bnkhd->bnqhgd', p.astype(v.dtype), vw)
    return o.reshape(B, S, H * d)


def hybrid_mixer(h, cos_m, sin_m, cos_s, sin_s, w_in, q_norm, w_q_b, kv_norm, w_kv_b,
                 sinks, forget_bias, w_out):
    B, S, _ = h.shape
    proj = h @ w_in
    (c_q, c_kv, k_rope, q_s, k_s, v_s, q_f, k_f, v_f, f_logit) = jnp.split(proj, IN_OFFSETS, axis=-1)

    q = (rmsnorm(c_q, q_norm) @ w_q_b).reshape(B, S, MLA_HEADS, MLA_NOPE_DIM + MLA_ROPE_DIM)
    q_nope, q_pe = q[..., :MLA_NOPE_DIM], apply_rope(q[..., MLA_NOPE_DIM:], cos_m, sin_m)
    kv = (rmsnorm(c_kv, kv_norm) @ w_kv_b).reshape(B, S, MLA_HEADS, MLA_NOPE_DIM + MLA_V_DIM)
    k_nope, v_m = kv[..., :MLA_NOPE_DIM], kv[..., MLA_NOPE_DIM:]
    k_pe = apply_rope(k_rope[:, :, None, :], cos_m, sin_m)
    q_m = jnp.concatenate([q_nope, q_pe], axis=-1)
    k_m = jnp.concatenate([k_nope, jnp.broadcast_to(k_pe, (B, S, MLA_HEADS, MLA_ROPE_DIM))], axis=-1)
    o_mla = causal_block_attention(q_m, k_m, v_m, (MLA_NOPE_DIM + MLA_ROPE_DIM) ** -0.5)

    q_s = apply_rope(q_s.reshape(B, S, SWA_HEADS, SWA_HEAD_DIM), cos_s, sin_s)
    k_s = apply_rope(k_s.reshape(B, S, SWA_KV_HEADS, SWA_HEAD_DIM), cos_s, sin_s)
    v_s = v_s.reshape(B, S, SWA_KV_HEADS, SWA_HEAD_DIM)
    o_swa = sliding_window_sink_attention(q_s, k_s, v_s, sinks)

    log_f = jax.nn.log_sigmoid(f_logit.astype(jnp.float32) + forget_bias.astype(jnp.float32))
    c = jnp.cumsum(log_f, axis=1)
    o_fox = causal_block_attention(q_f.reshape(B, S, FOX_HEADS, FOX_HEAD_DIM),
                                   k_f.reshape(B, S, FOX_HEADS, FOX_HEAD_DIM),
                                   v_f.reshape(B, S, FOX_HEADS, FOX_HEAD_DIM),
                                   FOX_HEAD_DIM ** -0.5, c)

    mixed = jnp.concatenate([o_mla.reshape(B, S, -1), o_swa, o_fox.reshape(B, S, -1)], axis=-1)
    return mixed @ w_out


def setup_inputs(seed: int = 0) -> dict:
    key = jax.random.key(seed)
    ks = jax.random.split(key, 24)
    f32 = jnp.float32

    def w(k, fan_in, fan_out):
        return jax.random.normal(k, (DEPTH, fan_in, fan_out), f32) * fan_in ** -0.5

    def gain(k, dim):
        return 1.0 + 0.1 * jax.random.normal(k, (DEPTH, dim), f32)

    return {
        "x": jax.random.normal(ks[0], (BATCH, SEQ, D_MODEL), f32),
        "positions": jnp.broadcast_to(jnp.arange(SEQ, dtype=jnp.int32), (BATCH, SEQ)),
        "ffn1_norm": gain(ks[1], D_MODEL),
        "ffn1_w_gate": w(ks[2], D_MODEL, D_FF),
        "ffn1_w_up": w(ks[3], D_MODEL, D_FF),
        "ffn1_w_down": w(ks[4], D_FF, D_MODEL),
        "mix_norm": gain(ks[5], D_MODEL),
        "w_in": w(ks[6], D_MODEL, IN_COLS),
        "mla_q_norm": gain(ks[7], MLA_Q_LORA),
        "mla_w_q_b": w(ks[8], MLA_Q_LORA, MLA_HEADS * (MLA_NOPE_DIM + MLA_ROPE_DIM)),
        "mla_kv_norm": gain(ks[9], MLA_KV_LORA),
        "mla_w_kv_b": w(ks[10], MLA_KV_LORA, MLA_HEADS * (MLA_NOPE_DIM + MLA_V_DIM)),
        "swa_sinks": 0.5 * jax.random.normal(ks[11], (DEPTH, SWA_HEADS), f32),
        "fox_forget_bias": 0.1 * jax.random.normal(ks[12], (DEPTH, FOX_HEADS), f32),
        "w_out": w(ks[13], MIX_WIDTH, D_MODEL),
        "ffn2_norm": gain(ks[14], D_MODEL),
        "ffn2_w_gate": w(ks[15], D_MODEL, D_FF),
        "ffn2_w_up": w(ks[16], D_MODEL, D_FF),
        "ffn2_w_down": w(ks[17], D_FF, D_MODEL),
        "final_norm": 1.0 + 0.1 * jax.random.normal(ks[18], (D_MODEL,), f32),
    }


def reference(x, positions, ffn1_norm, ffn1_w_gate, ffn1_w_up, ffn1_w_down, mix_norm, w_in,
              mla_q_norm, mla_w_q_b, mla_kv_norm, mla_w_kv_b, swa_sinks, fox_forget_bias, w_out,
              ffn2_norm, ffn2_w_gate, ffn2_w_up, ffn2_w_down, final_norm):
    cos_m, sin_m = rope_tables(positions, MLA_ROPE_DIM)
    cos_s, sin_s = rope_tables(positions, SWA_HEAD_DIM)
    for l in range(DEPTH):
        x = x + 0.5 * swiglu(rmsnorm(x, ffn1_norm[l]), ffn1_w_gate[l], ffn1_w_up[l], ffn1_w_down[l])
        x = x + hybrid_mixer(rmsnorm(x, mix_norm[l]), cos_m, sin_m, cos_s, sin_s, w_in[l],
                             mla_q_norm[l], mla_w_q_b[l], mla_kv_norm[l], mla_w_kv_b[l],
                             swa_sinks[l], fox_forget_bias[l], w_out[l])
        x = x + 0.5 * swiglu(rmsnorm(x, ffn2_norm[l]), ffn2_w_gate[l], ffn2_w_up[l], ffn2_w_down[l])
    return rmsnorm(x, final_norm)
```

```cpp
#include <hip/hip_runtime.h>
#include <hip/hip_cooperative_groups.h>
#include <cstdio>
#include <cstdint>
#include <cmath>
namespace cg = cooperative_groups;
namespace pg8 {
#define PG8_LAS __attribute__((address_space(3)))
typedef unsigned short bf16_t;
typedef short bf16x8 __attribute__((ext_vector_type(8)));
typedef float f32x4 __attribute__((ext_vector_type(4)));
typedef unsigned u32x4 __attribute__((ext_vector_type(4)));
constexpr int BM = 256, BK = 64, HALF = 128, HTB = HALF * BK * 2  , STAGE_BYTES = 8 * HTB, NXCD = 8, WGM = 8;

__host__ __device__ __forceinline__ int lds_byte(int r, int c) { const int st = (r >> 4) * 2 + (c >> 5), rr = r & 15, cc = c & 31, ob = rr * 64 + cc * 2; return st * 1024 + (ob ^ (((ob >> 9) & 1) << 5)); }
__host__ __device__ __forceinline__ void stage_rc(int b, int& R, int& C) { const int st = b / 1024, sb = b % 1024, swz = sb ^ (((sb >> 9) & 1) << 5); R = (st >> 1) * 16 + swz / 64; C = (st & 1) * 32 + (swz % 64) / 2; }
__host__ __device__ __forceinline__ int perm32(int rho) { const int n = rho >> 4, i = rho & 15; return 8 * (i >> 2) + 4 * n + (i & 3); }

struct Unit { int pm, pn; };
struct Gemm { const bf16_t* A; const bf16_t* Bt; int M, N, K; int atiled; };

struct StaticOrder {
    int nM, nN, nwg, G, c;
    __host__ __device__ void init(int M, int N, int G_, int c_) { nM = M / BM; nN = N / BM; nwg = nM * nN; G = G_; c = c_; }
    __host__ __device__ bool next(int i, Unit& u) const {
        const long L = (long)i * G + c; if (L >= nwg) return false;
        int wgid = (int)L; { const int q = nwg / NXCD, r = nwg % NXCD, xcd = wgid % NXCD, off = wgid / NXCD; wgid = (xcd < r ? xcd * (q + 1) : r * (q + 1) + (xcd - r) * q) + off; }
        const int nig = WGM * nN, gid = wgid / nig, fm = gid * WGM, gsz = (nM - fm) < WGM ? (nM - fm) : WGM;
        u.pm = fm + ((wgid % nig) % gsz); u.pn = (wgid % nig) / gsz; return true;
    }
    __device__ __forceinline__ void a_ready(const Unit&) const {}
    __device__ __forceinline__ void done(const Unit&) const {}
};
template <class Epi, class Sched, bool ALIGN_EPI = false, bool SP2 = false>
__device__ __forceinline__ void gemm_phase(PG8_LAS unsigned char* lds, const Gemm g, const Sched& S, const Epi& E) {
    int tid_l = threadIdx.x; asm volatile("" : "+v"(tid_l));
    const int tid = tid_l, wid = __builtin_amdgcn_readfirstlane(tid >> 6), lane = tid & 63, wr = wid >> 2, wc = wid & 3, fr = lane & 15, fq = lane >> 4;
    const int K = g.K, nt = K / BK;
    unsigned voffA[2], voffB[2];
#pragma unroll
    for (int i = 0; i < 2; ++i) { int R, C; stage_rc(tid * 16 + i * 8192, R, C); const int Rb = Epi::PERM ? ((R & ~31) + perm32(R & 31)) : R;
        voffA[i] = (unsigned)(R * (g.atiled ? 64 : K) + C) * 2u; voffB[i] = (unsigned)(Rb * 64 + C) * 2u; }
    const size_t kstepA = g.atiled ? (size_t)(BM * BK * 2) : (size_t)(BK * 2), kstepB = (size_t)(BM * BK * 2);
    const size_t hstepA = g.atiled ? (size_t)(HALF * BK * 2) : (size_t)HALF * K * 2, hstepB = (size_t)(HALF * BK * 2);
    const size_t tstepA = (size_t)BM * K * 2, tstepB = (size_t)BM * K * 2;
    const unsigned ldsw = (unsigned)wid * 1024u;
    const int aoff = lds_byte(wr * 64 + fr, fq * 8), boff = lds_byte(wc * 32 + fr, fq * 8);
#define PG8_SA(b, h) (((b) * 2 + (h)) * HTB)
#define PG8_SB(b, h) ((4 + (b) * 2 + (h)) * HTB)
#define PG8_STAGE(bufoff, gbase, voff) do { _Pragma("unroll") for (int _i = 0; _i < 2; ++_i) \
        __builtin_amdgcn_global_load_lds((const unsigned*)((const char*)(gbase) + (voff)[_i]), (PG8_LAS unsigned*)(lds + (bufoff) + ldsw + _i * 8192), 16, 0, 0); } while (0)
#define PG8_LDA(dst, b, h) do { _Pragma("unroll") for (int m = 0; m < 4; ++m) _Pragma("unroll") for (int k = 0; k < 2; ++k) dst[m][k] = *(const PG8_LAS bf16x8*)(lds + PG8_SA(b, h) + aoff + m * 2048 + k * 1024); } while (0)
#define PG8_LDB(dst, b, h) do { _Pragma("unroll") for (int n = 0; n < 2; ++n) _Pragma("unroll") for (int k = 0; k < 2; ++k) dst[n][k] = *(const PG8_LAS bf16x8*)(lds + PG8_SB(b, h) + boff + n * 2048 + k * 1024); } while (0)
#define PG8_MMA(ai, bj, At, Bt) do { __builtin_amdgcn_s_setprio(1); _Pragma("unroll") for (int m = 0; m < 4; ++m) _Pragma("unroll") for (int n = 0; n < 2; ++n) _Pragma("unroll") for (int k = 0; k < 2; ++k) \
        acc[ai][bj][m][n] = __builtin_amdgcn_mfma_f32_16x16x32_bf16(Bt[n][k], At[m][k], acc[ai][bj][m][n], 0, 0, 0); __builtin_amdgcn_s_setprio(0); } while (0)
#define PG8_WAIT_V(n) asm volatile("s_waitcnt vmcnt(" #n ")" ::: "memory")
#define PG8_WAIT_L(n) asm volatile("s_waitcnt lgkmcnt(" #n ")" ::: "memory")
#define PG8_BAR __builtin_amdgcn_s_barrier()
#define PG8_SCHED __builtin_amdgcn_sched_barrier(0)
    Unit cur, nxt; int ui = 0;
    if (!S.next(0, cur)) return;
    f32x4 acc[2][2][4][2];
#pragma unroll
    for (int a = 0; a < 2; ++a)
#pragma unroll
        for (int b = 0; b < 2; ++b)
#pragma unroll
            for (int m = 0; m < 4; ++m)
#pragma unroll
                for (int n = 0; n < 2; ++n) acc[a][b][m][n] = (f32x4){0.f, 0.f, 0.f, 0.f};
    bf16x8 At[4][2], B0[2][2], B1[2][2];
    const char* cA = (const char*)g.A + (size_t)cur.pm * tstepA; const char* cB = (const char*)g.Bt + (size_t)cur.pn * tstepB;
    S.a_ready(cur); E.prefetch(cur, 0, tid);
    if constexpr (SP2) {
        PG8_STAGE(PG8_SB(0, 0), cB, voffB); PG8_STAGE(PG8_SB(0, 1), cB + hstepB, voffB); PG8_STAGE(PG8_SA(0, 0), cA, voffA); PG8_STAGE(PG8_SA(0, 1), cA + hstepA, voffA);
        if (wr == 1) PG8_BAR;
        PG8_WAIT_V(2); PG8_BAR;
        PG8_STAGE(PG8_SB(1, 0), cB + kstepB, voffB); PG8_STAGE(PG8_SA(1, 0), cA + kstepA, voffA); PG8_STAGE(PG8_SB(1, 1), cB + hstepB + kstepB, voffB);
        PG8_WAIT_V(6); PG8_BAR;
    } else {
        PG8_STAGE(PG8_SB(0, 0), cB, voffB); PG8_STAGE(PG8_SA(0, 0), cA, voffA); PG8_STAGE(PG8_SB(0, 1), cB + hstepB, voffB); PG8_STAGE(PG8_SA(0, 1), cA + hstepA, voffA);
        if (wr == 1) PG8_BAR;
        PG8_WAIT_V(4); PG8_BAR;
        PG8_STAGE(PG8_SB(1, 0), cB + kstepB, voffB); PG8_STAGE(PG8_SA(1, 0), cA + kstepA, voffA); PG8_STAGE(PG8_SB(1, 1), cB + hstepB + kstepB, voffB);
        PG8_WAIT_V(6); PG8_BAR;
    }
    for (;;) {
        const bool has_next = S.next(ui + 1, nxt);
        const char* nA = has_next ? (const char*)g.A + (size_t)nxt.pm * tstepA : cA; const char* nB = has_next ? (const char*)g.Bt + (size_t)nxt.pn * tstepB : cB;
        for (int t = 0; t < nt; t += 2) {
            const bool last = (t == nt - 2);
            const char* a1 = cA + (size_t)(t + 1) * kstepA;
            const char* a2 = last ? nA : cA + (size_t)(t + 2) * kstepA; const char* b2 = last ? nB : cB + (size_t)(t + 2) * kstepB;
            const char* a3 = a2 + kstepA; const char* b3 = b2 + kstepB;
            if (last && has_next) { S.a_ready(nxt); E.prefetch(nxt, ui + 1, tid); }
            if constexpr (SP2) {
            PG8_LDB(B0, 0, 0); PG8_LDB(B1, 0, 1); PG8_SCHED; PG8_LDA(At, 0, 0); PG8_STAGE(PG8_SA(1, 1), a1 + hstepA, voffA);
            PG8_WAIT_V(8); PG8_WAIT_L(0); PG8_BAR; PG8_MMA(0, 0, At, B0); PG8_MMA(0, 1, At, B1); PG8_BAR; PG8_SCHED;
            PG8_LDA(At, 0, 1); PG8_STAGE(PG8_SB(0, 0), b2, voffB); PG8_STAGE(PG8_SB(0, 1), b2 + hstepB, voffB); PG8_STAGE(PG8_SA(0, 0), a2, voffA);
            PG8_WAIT_V(8); PG8_WAIT_L(0); PG8_BAR; PG8_MMA(1, 0, At, B0); PG8_MMA(1, 1, At, B1); PG8_BAR; PG8_SCHED;
            PG8_LDB(B0, 1, 0); PG8_LDB(B1, 1, 1); PG8_SCHED; PG8_LDA(At, 1, 0); PG8_STAGE(PG8_SA(0, 1), a2 + hstepA, voffA);
            PG8_WAIT_V(8); PG8_WAIT_L(0); PG8_BAR; PG8_MMA(0, 0, At, B0); PG8_MMA(0, 1, At, B1); PG8_BAR; PG8_SCHED;
            PG8_LDA(At, 1, 1); PG8_STAGE(PG8_SB(1, 0), b3, voffB); PG8_STAGE(PG8_SB(1, 1), b3 + hstepB, voffB); PG8_STAGE(PG8_SA(1, 0), a3, voffA);
            PG8_WAIT_V(8); PG8_WAIT_L(0); PG8_BAR; PG8_MMA(1, 0, At, B0); PG8_MMA(1, 1, At, B1); PG8_BAR; PG8_SCHED;
            } else {
            PG8_LDB(B0, 0, 0); PG8_SCHED; PG8_LDA(At, 0, 0); PG8_STAGE(PG8_SA(1, 1), a1 + hstepA, voffA);
            PG8_WAIT_L(8); PG8_BAR; PG8_WAIT_L(0); PG8_MMA(0, 0, At, B0); PG8_BAR; PG8_SCHED;
            PG8_LDB(B1, 0, 1); PG8_STAGE(PG8_SB(0, 0), b2, voffB);
            PG8_BAR; PG8_WAIT_L(0); PG8_MMA(0, 1, At, B1); PG8_BAR;
            PG8_LDA(At, 0, 1); PG8_STAGE(PG8_SA(0, 0), a2, voffA);
            PG8_BAR; PG8_WAIT_L(0); PG8_MMA(1, 0, At, B0); PG8_BAR; PG8_SCHED;
            PG8_STAGE(PG8_SB(0, 1), b2 + hstepB, voffB);
            PG8_WAIT_V(6); PG8_BAR; PG8_MMA(1, 1, At, B1); PG8_BAR;
            PG8_LDB(B0, 1, 0); PG8_SCHED; PG8_LDA(At, 1, 0); PG8_STAGE(PG8_SA(0, 1), a2 + hstepA, voffA);
            PG8_WAIT_L(8); PG8_BAR; PG8_WAIT_L(0); PG8_MMA(0, 0, At, B0); PG8_BAR; PG8_SCHED;
            PG8_LDB(B1, 1, 1); PG8_STAGE(PG8_SB(1, 0), b3, voffB);
            PG8_BAR; PG8_WAIT_L(0); PG8_MMA(0, 1, At, B1); PG8_BAR;
            PG8_LDA(At, 1, 1); PG8_STAGE(PG8_SA(1, 0), a3, voffA);
            PG8_BAR; PG8_WAIT_L(0); PG8_MMA(1, 0, At, B0); PG8_BAR; PG8_SCHED;
            PG8_STAGE(PG8_SB(1, 1), b3 + hstepB, voffB);
            PG8_WAIT_V(6); PG8_BAR; PG8_MMA(1, 1, At, B1); PG8_BAR;
            }
        }
        if constexpr (ALIGN_EPI) { if (wr == 0) PG8_BAR; }
        if constexpr (!Epi::AFTER_DRAIN) { E(acc, cur, wr, wc, fr, fq, ui); S.done(cur); }
        if (!has_next) break;
#pragma unroll
        for (int a = 0; a < 2; ++a)
#pragma unroll
            for (int b = 0; b < 2; ++b)
#pragma unroll
                for (int m = 0; m < 4; ++m)
#pragma unroll
                    for (int n = 0; n < 2; ++n) acc[a][b][m][n] = (f32x4){0.f, 0.f, 0.f, 0.f};
        cur = nxt; cA = nA; cB = nB; ++ui;
        if constexpr (ALIGN_EPI) { if (wr == 1) PG8_BAR; }
    }
    PG8_WAIT_V(0);
    if constexpr (!ALIGN_EPI) { if (wr == 0) PG8_BAR; }
    PG8_BAR;
    if constexpr (Epi::AFTER_DRAIN) { E.fused(acc, cur, wr, wc, fr, fq, lds, wid, lane); S.done(cur); }
#undef PG8_SA
#undef PG8_SB
#undef PG8_STAGE
#undef PG8_LDA
#undef PG8_LDB
#undef PG8_MMA
#undef PG8_WAIT_V
#undef PG8_WAIT_L
#undef PG8_BAR
#undef PG8_SCHED
}
}
#define LAS __attribute__((address_space(3)))
#ifndef PROBE_MASK
#define PROBE_MASK 0
#endif
using pg8::bf16_t; using pg8::bf16x8; using pg8::f32x4; using pg8::u32x4; using pg8::Unit;
typedef unsigned u32x2 __attribute__((ext_vector_type(2)));
typedef float f32x2 __attribute__((ext_vector_type(2)));
typedef float f32x16 __attribute__((ext_vector_type(16)));
typedef short v4i16_t __attribute__((ext_vector_type(4)));
typedef __bf16 bf16x2_t __attribute__((ext_vector_type(2)));

constexpr int M = 16384, SEQ = 8192, DM = 2048, DFF = 5632, NGU = 11264, NIN = 3328, DEPTH = 2;
constexpr int NIN_SRC = 3144;
constexpr float RMS_EPS = 1e-6f;
constexpr float LOG2E = 1.4426950408889634f;
constexpr float QSCALE_M = 0.07216878364870322f * LOG2E;
constexpr float QSCALE_64 = 0.125f * LOG2E;

constexpr size_t SZ_WGU = (size_t)NGU * DM * 2, SZ_WD = (size_t)DM * DFF * 2, SZ_WIN = (size_t)NIN * DM * 2, SZ_WQB = (size_t)1536 * 512 * 2,
                 SZ_WKV = (size_t)2048 * 256 * 2, SZ_WOUT = (size_t)2048 * 2048 * 2;
constexpr size_t LW_GU1 = 0, LW_D1 = LW_GU1 + SZ_WGU, LW_IN = LW_D1 + SZ_WD, LW_QB = LW_IN + SZ_WIN, LW_KV = LW_QB + SZ_WQB, LW_OUT = LW_KV + SZ_WKV,
                 LW_GU2 = LW_OUT + SZ_WOUT, LW_D2 = LW_GU2 + SZ_WGU, LAYER_W = LW_D2 + SZ_WD;
constexpr size_t WS_CTL = 0, WS_W = 1u << 20, WS_XB = WS_W + DEPTH * LAYER_W, WS_SS = WS_XB + (size_t)M * DM * 2, WS_ROPE = WS_SS + (size_t)M * 32 * 4,
                 WS_U = WS_ROPE + (size_t)M * 32 * 8;
constexpr size_t U_HID = 0;
constexpr size_t U_CQ = 0, U_CKV = U_CQ + (size_t)M * 512 * 2, U_SSQ = U_CKV + (size_t)M * 256 * 2, U_SSKV = U_SSQ + (size_t)M * 8 * 4, U_QS = U_SSKV + (size_t)M * 4 * 4,
                 U_KS = U_QS + (size_t)M * 512 * 2, U_VS = U_KS + (size_t)M * 128 * 2, U_KPE = U_VS + (size_t)M * 128 * 2, U_LOGF = U_KPE + (size_t)M * 64 * 2,
                 U_CUM = U_LOGF + (size_t)M * 8 * 4, U_CHS = U_CUM + (size_t)M * 8 * 4, U_QF = U_CHS + 4096, U_KF = U_QF + (size_t)M * 512 * 2, U_VF = U_KF + (size_t)M * 512 * 2,
                 U_QM = U_VF + (size_t)M * 512 * 2, U_KM = U_QM + (size_t)M * 1536 * 2, U_VM = U_KM + (size_t)M * 1024 * 2, U_MIX = U_VM + (size_t)M * 1024 * 2,
                 U_END_MIX = U_MIX + (size_t)M * 2048 * 2;
constexpr size_t U_BYTES = (U_END_MIX > (size_t)M * DFF * 2) ? U_END_MIX : (size_t)M * DFF * 2;
constexpr size_t WS_END = WS_U + U_BYTES;
constexpr int LDS_BYTES = 131072 + 4096;
constexpr int LDS_X = 131072;

__device__ __forceinline__ unsigned f2bf(float f) { unsigned u = __builtin_bit_cast(unsigned, f); return (u + 0x7fffu + ((u >> 16) & 1u)) >> 16; }
__device__ __forceinline__ unsigned pk2(float lo, float hi) { f32x2 v = {lo, hi}; bf16x2_t b = __builtin_convertvector(v, bf16x2_t); return __builtin_bit_cast(unsigned, b); }
__device__ __forceinline__ float wave_sum(float v) {
#pragma unroll
    for (int o = 1; o < 64; o <<= 1) v += __shfl_xor(v, o);
    return v;
}
__device__ __forceinline__ float sum_ss(const float* p, int n4) {
    f32x4 s = {0.f, 0.f, 0.f, 0.f};
    for (int i = 0; i < n4; ++i) s += *(const f32x4*)(p + 4 * i);
    return (s[0] + s[1]) + (s[2] + s[3]);
}

struct MixBufs { unsigned char* U; };
#define MB_BF(name, off) __device__ __forceinline__ bf16_t* name(const MixBufs& b) { return (bf16_t*)(b.U + (off)); }
#define MB_F32(name, off) __device__ __forceinline__ float* name(const MixBufs& b) { return (float*)(b.U + (off)); }
MB_BF(mCQ, U_CQ) MB_BF(mCKV, U_CKV) MB_BF(mQS, U_QS) MB_BF(mKS, U_KS) MB_BF(mVS, U_VS) MB_BF(mKPE, U_KPE) MB_BF(mQF, U_QF) MB_BF(mKF, U_KF) MB_BF(mVF, U_VF)
MB_BF(mQM, U_QM) MB_BF(mKM, U_KM) MB_BF(mVM, U_VM) MB_BF(mMIX, U_MIX) MB_F32(mSSQ, U_SSQ) MB_F32(mSSKV, U_SSKV) MB_F32(mLOGF, U_LOGF) MB_F32(mCUM, U_CUM) MB_F32(mCHS, U_CHS) MB_F32(mKNM, U_CHS + 1024)
#define EPI_ROW(it) (u.pm * 256 + ((it) >> 2) * 128 + wr * 64 + ((it) & 3) * 16 + fr)
#define EPI_LROW(it) (((it) >> 2) * 128 + wr * 64 + ((it) & 3) * 16 + fr)
__device__ __forceinline__ int opaque(int r) { asm volatile("" : "+v"(r)); return r; }
__device__ __forceinline__ u32x4 pack8(const f32x4& a, const f32x4& b, float sc) { u32x4 w; w[0] = pk2(a[0] * sc, a[1] * sc); w[1] = pk2(a[2] * sc, a[3] * sc); w[2] = pk2(b[0] * sc, b[1] * sc); w[3] = pk2(b[2] * sc, b[3] * sc); return w; }
__device__ __forceinline__ float sq8(const f32x4& a, const f32x4& b, float sc) { float q = 0.f;
#pragma unroll
    for (int i = 0; i < 4; ++i) { const float x = a[i] * sc, y = b[i] * sc; q += x * x + y * y; } return q; }
struct Rope8 { f32x4 t[4]; };
__device__ __forceinline__ void rope_load(Rope8& R, const f32x2* ROPE, int r, int dd0) { const f32x4* p = (const f32x4*)(ROPE + (size_t)r * 32 + dd0);
#pragma unroll
    for (int i = 0; i < 4; ++i) R.t[i] = p[i]; }
__device__ __forceinline__ void rope8(const f32x4 (&a1)[2], const f32x4 (&a2)[2], float sc, const Rope8& R, u32x4& w1, u32x4& w2) {
    float o1[8], o2[8];
#pragma unroll
    for (int n = 0; n < 2; ++n) {
        const f32x4 t0 = R.t[2 * n], t1 = R.t[2 * n + 1];
        const float c[4] = {t0[0], t0[2], t1[0], t1[2]}, s[4] = {t0[1], t0[3], t1[1], t1[3]};
#pragma unroll
        for (int i = 0; i < 4; ++i) { const float x1 = a1[n][i] * sc, x2 = a2[n][i] * sc; o1[4 * n + i] = x1 * c[i] - x2 * s[i]; o2[4 * n + i] = x2 * c[i] + x1 * s[i]; }
    }
    w1[0] = pk2(o1[0], o1[1]); w1[1] = pk2(o1[2], o1[3]); w1[2] = pk2(o1[4], o1[5]); w1[3] = pk2(o1[6], o1[7]);
    w2[0] = pk2(o2[0], o2[1]); w2[1] = pk2(o2[2], o2[3]); w2[2] = pk2(o2[4], o2[5]); w2[3] = pk2(o2[6], o2[7]);
}
__device__ __forceinline__ void epi_swiglu(bf16_t* H, const LAS float* tbl, const f32x4 (&acc)[2][2][4][2], const Unit& u, int wr, int wc, int fr, int fq) {
    const int col0 = u.pn * 128 + wc * 32 + fq * 8;
#pragma unroll
    for (int it = 0; it < 8; ++it) {
        const int ai = it >> 2, m = it & 3; const int r = opaque(EPI_ROW(it));
        const float rs = tbl[EPI_LROW(it)];
        u32x4 w;
#pragma unroll
        for (int n = 0; n < 2; ++n) {
            const f32x4 g = acc[ai][0][m][n] * rs, up = acc[ai][1][m][n] * rs; float hv[4];
#pragma unroll
            for (int i = 0; i < 4; ++i) hv[i] = g[i] * __builtin_amdgcn_rcpf(1.0f + __expf(-g[i])) * up[i];
            w[2 * n] = pk2(hv[0], hv[1]); w[2 * n + 1] = pk2(hv[2], hv[3]);
        }
        *(u32x4*)(H + ((size_t)(r >> 8) * (DFF / 64) + (col0 >> 6)) * 16384 + (r & 255) * 64 + (col0 & 63)) = w;
    }
}
__device__ __forceinline__ f32x4 bf_lo4(const u32x4& w) { return (f32x4){__uint_as_float(w[0] << 16), __uint_as_float(w[0] & 0xffff0000u), __uint_as_float(w[1] << 16), __uint_as_float(w[1] & 0xffff0000u)}; }
__device__ __forceinline__ f32x4 bf_hi4(const u32x4& w) { return (f32x4){__uint_as_float(w[2] << 16), __uint_as_float(w[2] & 0xffff0000u), __uint_as_float(w[3] << 16), __uint_as_float(w[3] & 0xffff0000u)}; }
__device__ __forceinline__ void epi_resid(bf16_t* XB, float* SS, float alpha, const f32x4 (&acc)[2][2][4][2], const Unit& u, int wr, int wc, int fr, int fq) {
    const int c0 = u.pn * 256 + wc * 32 + fq * 8;
    u32x4 pre[2][2];
    { const bf16_t* p = XB + (size_t)opaque(EPI_ROW(0)) * DM + c0; pre[0][0] = *(const u32x4*)p; pre[0][1] = *(const u32x4*)(p + 128); }
#pragma unroll
    for (int it = 0; it < 8; ++it) {
        const int ai = it >> 2, m = it & 3; const int r = opaque(EPI_ROW(it));
        if (it + 1 < 8) { const bf16_t* p = XB + (size_t)opaque(EPI_ROW(it + 1)) * DM + c0; pre[(it + 1) & 1][0] = *(const u32x4*)p; pre[(it + 1) & 1][1] = *(const u32x4*)(p + 128); }
        float q = 0.f;
#pragma unroll
        for (int bj = 0; bj < 2; ++bj) {
            const size_t off = (size_t)r * DM + c0 + bj * 128;
            const u32x4 bw = pre[it & 1][bj];
            const f32x4 o0 = bf_lo4(bw) + acc[ai][bj][m][0] * alpha, o1 = bf_hi4(bw) + acc[ai][bj][m][1] * alpha;
            u32x4 w; w[0] = pk2(o0[0], o0[1]); w[1] = pk2(o0[2], o0[3]); w[2] = pk2(o1[0], o1[1]); w[3] = pk2(o1[2], o1[3]);
            *(u32x4*)(XB + off) = w;
            q += (o0[0] * o0[0] + o0[1] * o0[1]) + (o0[2] * o0[2] + o0[3] * o0[3]) + (o1[0] * o1[0] + o1[1] * o1[1]) + (o1[2] * o1[2] + o1[3] * o1[3]);
        }
        q += __shfl_xor(q, 16); q += __shfl_xor(q, 32);
        if (fq == 0) SS[(size_t)r * 32 + u.pn * 4 + wc] = q;
        asm volatile("" ::: "memory");
    }
}
__device__ __forceinline__ void epi_win(const MixBufs B, const LAS float* tbl, const f32x2* ROPE, const float* fbias, int pn_off, const f32x4 (&acc)[2][2][4][2], const Unit& u, int wr, int wc, int fr, int fq) {
    const int pn = u.pn + pn_off;
    int mode = 3, ld = 0, off1 = 0, ssld = 0; bf16_t* dst = nullptr; float* ssp = nullptr; float scm = 1.0f;
    if (pn < 2) { mode = 0; dst = mCQ(B) + pn * 256 + wc * 32; ld = 512; off1 = 128; ssp = mSSQ(B) + pn * 4 + wc; ssld = 8; }
    else if (pn == 2) { mode = 0; dst = mCKV(B) + wc * 32; ld = 256; off1 = 128; ssp = mSSKV(B) + wc; ssld = 4; }
    else if (pn < 5) { mode = 1; dst = mQS(B) + ((pn - 3) * 4 + wc) * 64; ld = 512; scm = QSCALE_64; }
    else if (pn == 5) { if (wc < 2) { mode = 1; dst = mKS(B) + wc * 64; ld = 128; } else { mode = 0; dst = mVS(B) + (wc - 2) * 32; ld = 128; off1 = 64; } }
    else if (pn == 12) { if (wc == 0) { mode = 1; dst = mKPE(B); ld = 64; } else if (wc == 1) mode = 2; }
    else { const int t = (pn - 6) >> 1, half = (pn - 6) & 1; mode = 0; dst = (t == 0 ? mQF(B) : (t == 1 ? mKF(B) : mVF(B))) + half * 256 + wc * 32; ld = 512; off1 = 128; if (t == 0) scm = QSCALE_64; }
    const int loff = fq * 8;
    Rope8 R[2];
    if (mode == 1) rope_load(R[0], ROPE, opaque(EPI_ROW(0)), fq * 8);
#pragma unroll
    for (int it = 0; it < 8; ++it) {
        const int ai = it >> 2, m = it & 3; const int r = opaque(EPI_ROW(it));
        if (mode == 1 && it + 1 < 8) rope_load(R[(it + 1) & 1], ROPE, opaque(EPI_ROW(it + 1)), fq * 8);
        const float rs = tbl[EPI_LROW(it)] * scm;
        const f32x4 (&a0)[2] = acc[ai][0][m]; const f32x4 (&a1)[2] = acc[ai][1][m];
        bf16_t* p = dst + (size_t)r * ld + loff;
        if (mode == 0) {
            *(u32x4*)p = pack8(a0[0], a0[1], rs); *(u32x4*)(p + off1) = pack8(a1[0], a1[1], rs);
            if (ssp) { float q = sq8(a0[0], a0[1], rs) + sq8(a1[0], a1[1], rs); q += __shfl_xor(q, 16); q += __shfl_xor(q, 32); if (fq == 0) ssp[(size_t)r * ssld] = q; }
        } else if (mode == 1) {
            u32x4 w1, w2; rope8(a0, a1, rs, R[it & 1], w1, w2); *(u32x4*)p = w1; *(u32x4*)(p + 32) = w2;
        } else if (mode == 2 && fq == 0) {
            float lf[8];
#pragma unroll
            for (int n = 0; n < 2; ++n)
#pragma unroll
                for (int i = 0; i < 4; ++i) { const float x = a0[n][i] * rs + fbias[4 * n + i]; lf[4 * n + i] = fminf(x, 0.f) - log1pf(expf(-fabsf(x))); }
            *(f32x4*)(mLOGF(B) + (size_t)r * 8) = (f32x4){lf[0], lf[1], lf[2], lf[3]}; *(f32x4*)(mLOGF(B) + (size_t)r * 8 + 4) = (f32x4){lf[4], lf[5], lf[6], lf[7]};
        }
        asm volatile("" ::: "memory");
    }
}
__device__ __forceinline__ void epi_qb(const MixBufs B, const f32x2* ROPE, const f32x4 (&acc)[2][2][4][2], const Unit& u, int wr, int wc, int fr, int fq) {
    const int pn = u.pn;
    const bool roped = pn >= 4;
    bf16_t* dst = roped ? mQM(B) + ((pn - 4) * 4 + wc) * 192 + 128 : mQM(B) + (2 * pn) * 192 + wc * 32;
    const int loff = fq * 8;
    Rope8 R[2]; f32x4 sq[2][2];
    { const int r0 = opaque(EPI_ROW(0)); if (roped) rope_load(R[0], ROPE, r0, fq * 8); const f32x4* p = (const f32x4*)(mSSQ(B) + (size_t)r0 * 8); sq[0][0] = p[0]; sq[0][1] = p[1]; }
#pragma unroll
    for (int it = 0; it < 8; ++it) {
        const int ai = it >> 2, m = it & 3; const int r = opaque(EPI_ROW(it));
        if (it + 1 < 8) { const int rn = opaque(EPI_ROW(it + 1)); if (roped) rope_load(R[(it + 1) & 1], ROPE, rn, fq * 8);
            const f32x4* p = (const f32x4*)(mSSQ(B) + (size_t)rn * 8); sq[(it + 1) & 1][0] = p[0]; sq[(it + 1) & 1][1] = p[1]; }
        const f32x4 sv = sq[it & 1][0] + sq[it & 1][1];
        const float rs = rsqrtf(((sv[0] + sv[1]) + (sv[2] + sv[3])) * (1.0f / 512) + RMS_EPS) * QSCALE_M;
        const f32x4 (&a0)[2] = acc[ai][0][m]; const f32x4 (&a1)[2] = acc[ai][1][m];
        bf16_t* p = dst + (size_t)r * 1536 + loff;
        if (!roped) { *(u32x4*)p = pack8(a0[0], a0[1], rs); *(u32x4*)(p + 192) = pack8(a1[0], a1[1], rs); }
        else { u32x4 w1, w2; rope8(a0, a1, rs, R[it & 1], w1, w2); *(u32x4*)p = w1; *(u32x4*)(p + 32) = w2; }
        asm volatile("" ::: "memory");
    }
}
__device__ __forceinline__ void epi_kvb(const MixBufs B, const f32x4 (&acc)[2][2][4][2], const Unit& u, int wr, int wc, int fr, int fq) {
    const int pn = u.pn, c8 = wc * 32 + fq * 8;
    bf16_t* dst = pn < 4 ? mKM(B) : mVM(B); const int hp = pn & 3;
    f32x4 sq[2];
    sq[0] = *(const f32x4*)(mSSKV(B) + (size_t)opaque(EPI_ROW(0)) * 4);
#pragma unroll
    for (int it = 0; it < 8; ++it) {
        const int ai = it >> 2, m = it & 3; const int r = opaque(EPI_ROW(it));
        if (it + 1 < 8) sq[(it + 1) & 1] = *(const f32x4*)(mSSKV(B) + (size_t)opaque(EPI_ROW(it + 1)) * 4);
        const f32x4 sv = sq[it & 1];
        const float rs = rsqrtf(((sv[0] + sv[1]) + (sv[2] + sv[3])) * (1.0f / 256) + RMS_EPS);
        *(u32x4*)(dst + (size_t)r * 1024 + (2 * hp) * 128 + c8) = pack8(acc[ai][0][m][0], acc[ai][0][m][1], rs);
        *(u32x4*)(dst + (size_t)r * 1024 + (2 * hp + 1) * 128 + c8) = pack8(acc[ai][1][m][0], acc[ai][1][m][1], rs);
        asm volatile("" ::: "memory");
    }
}
enum { EPI_SWIGLU = 0, EPI_RESID = 1, EPI_WIN = 2, EPI_QB = 3, EPI_KVB = 4 };
struct EpiAny {
    static constexpr bool PERM = true, AFTER_DRAIN = false;
    int kind; unsigned char* ws_; const float* base; float* out; float alpha; const float* fbias; LAS float* tbl; int pn_off;
    __device__ __forceinline__ void prefetch(const Unit& u, int idx, int tid) const {
        if (kind == EPI_SWIGLU || kind == EPI_WIN) {
#pragma unroll
            for (int pass = 0; pass < 2; ++pass) {
                const int row = pass * 128 + (tid >> 2), qtr = tid & 3;
                const f32x4* p = (const f32x4*)((const float*)(ws_ + WS_SS) + (size_t)(u.pm * 256 + row) * 32 + qtr * 8);
                const f32x4 sv = p[0] + p[1];
                float s = (sv[0] + sv[1]) + (sv[2] + sv[3]); s += __shfl_xor(s, 1); s += __shfl_xor(s, 2);
                if (qtr == 0) tbl[(idx & 1) * 256 + row] = rsqrtf(s * (1.0f / DM) + RMS_EPS);
                asm volatile("" ::: "memory");
            }
        }
    }
    __device__ __forceinline__ void operator()(const f32x4 (&acc)[2][2][4][2], const Unit& u, int wr, int wc, int fr, int fq, int ui) const {
        const LAS float* t = tbl + (ui & 1) * 256;
#define EPI_WS() unsigned char* ws = ws_; asm volatile("" : "+s"(ws))
        switch (kind) {
        case EPI_SWIGLU: { EPI_WS(); epi_swiglu((bf16_t*)(ws + WS_U + U_HID), t, acc, u, wr, wc, fr, fq); } break;
        case EPI_RESID: { EPI_WS(); epi_resid((bf16_t*)(ws + WS_XB), (float*)(ws + WS_SS), alpha, acc, u, wr, wc, fr, fq); } break;
        case EPI_WIN: { EPI_WS(); epi_win(MixBufs{ws + WS_U}, t, (const f32x2*)(ws + WS_ROPE), fbias, pn_off, acc, u, wr, wc, fr, fq); } break;
        case EPI_QB: { EPI_WS(); epi_qb(MixBufs{ws + WS_U}, (const f32x2*)(ws + WS_ROPE), acc, u, wr, wc, fr, fq); } break;
        default: { EPI_WS(); epi_kvb(MixBufs{ws + WS_U}, acc, u, wr, wc, fr, fq); } break;
        }
    }
};

enum { MAP_ID = 0, MAP_GU = 1, MAP_WIN = 2, MAP_QB = 3, MAP_KVB = 4 };
__device__ __forceinline__ int colmap(int kind, int r, int& which) {
    which = 0;
    const int tile = r >> 8, bj = (r >> 7) & 1, j = r & 127, wc = j >> 5, dd = j & 31;
    switch (kind) {
    case MAP_ID: return r;
    case MAP_GU: which = bj; return tile * 128 + j;
    case MAP_WIN:
        if (tile < 2) return r;
        if (tile == 2) return 512 + (r - 512);
        if (tile < 5) return 832 + ((tile - 3) * 4 + wc) * 64 + bj * 32 + dd;
        if (tile == 5) return wc < 2 ? 1344 + wc * 64 + bj * 32 + dd : 1472 + bj * 64 + (wc - 2) * 32 + dd;
        if (tile == 12) { if (bj == 0) return j < 32 ? 768 + j : (j < 40 ? 3136 + (j - 32) : -1); return j < 32 ? 768 + 32 + j : -1; }
        if (tile < 8) return 1600 + (r - 6 * 256);
        if (tile < 10) return 2112 + (r - 8 * 256);
        return 2624 + (r - 10 * 256);
    case MAP_QB:
        if (tile < 4) return (2 * tile + bj) * 192 + j;
        return ((tile - 4) * 4 + wc) * 192 + 128 + bj * 32 + dd;
    default:
        if (tile < 4) return (2 * tile + bj) * 256 + j;
        return (2 * (tile - 4) + bj) * 256 + 128 + j;
    }
}
struct TrJob { const float* W0; const float* W1; const float* gain; bf16_t* WT; int K, Nsrc, Ndst, kind; };
__device__ __forceinline__ void tr_item(const TrJob& J, LAS float* scr, int item, int lane) {
    const int nblk = J.Ndst / 64, kb = item / nblk, nb = item % nblk, k0 = 64 * kb, n0 = 64 * nb;
    const int n4 = (lane & 15) * 4, krow = lane >> 4;
    int which; const int sc = colmap(J.kind, n0 + n4, which);
    const float* W = J.W0 + (J.W1 ? (long long)which * (J.W1 - J.W0) : 0ll);
    f32x4 v[16];
#pragma unroll
    for (int i = 0; i < 16; ++i) v[i] = sc >= 0 ? *(const f32x4*)(W + (size_t)(k0 + 4 * i + krow) * J.Nsrc + sc) : (f32x4){0.f, 0.f, 0.f, 0.f};
    if (J.gain) {
#pragma unroll
        for (int i = 0; i < 16; ++i) v[i] *= J.gain[k0 + 4 * i + krow];
    }
#pragma unroll
    for (int i = 0; i < 16; ++i) { LAS float* d = scr + (4 * i + krow) * 65 + n4; d[0] = v[i][0]; d[1] = v[i][1]; d[2] = v[i][2]; d[3] = v[i][3]; }
    asm volatile("s_waitcnt lgkmcnt(0)" ::: "memory");
    const int c = lane & 7;
#pragma unroll
    for (int j = 0; j < 8; ++j) { const int n = (lane >> 3) + 8 * j; const LAS float* p = scr + (8 * c) * 65 + n;
        u32x4 o; o[0] = pk2(p[0 * 65], p[1 * 65]); o[1] = pk2(p[2 * 65], p[3 * 65]); o[2] = pk2(p[4 * 65], p[5 * 65]); o[3] = pk2(p[6 * 65], p[7 * 65]);
        *(u32x4*)(J.WT + ((size_t)((n0 + n) >> 8) * (J.K / 64) + kb) * 16384 + ((n0 + n) & 255) * 64 + 8 * c) = o; }
    asm volatile("s_waitcnt lgkmcnt(0)" ::: "memory");
}
__device__ const unsigned long long ROPE_F[32] = {2935890503282001226ull, 2201607287645322120ull, 1650972556229361476ull, 1238054759683200494ull, 928410095122917244ull, 696209354218470131ull, 522083363211519329ull, 391507290861131643ull, 293589050328200123ull, 220160728764532212ull, 165097255622936148ull, 123805475968320049ull, 92841009512291724ull, 69620935421847013ull, 52208336321151933ull, 39150729086113164ull, 29358905032820012ull, 22016072876453221ull, 16509725562293615ull, 12380547596832005ull, 9284100951229172ull, 6962093542184701ull, 5220833632115193ull, 3915072908611316ull, 2935890503282001ull, 2201607287645322ull, 1650972556229361ull, 1238054759683200ull, 928410095122917ull, 696209354218470ull, 522083363211519ull, 391507290861132ull};
constexpr int CTL_BAR_WORD = 1024;
#define XB_TMO      128
#define XB_XCNT(j)  (256  + 64 * (j))
#define XB_XSUB(j)  (1280 + 64 * (j))
#define XB_XGEN(j)  (2304 + 64 * (j))
#define XB_TOP      3328
#define XB_TOPGEN   3392
#define XCD_BAR_WORDS 3456
#define XB_SPIN_CAP (1u << 18)

__device__ __forceinline__ unsigned xb_ld(unsigned* p)              { return __hip_atomic_load(p, __ATOMIC_RELAXED, __HIP_MEMORY_SCOPE_AGENT); }
__device__ __forceinline__ unsigned xb_add(unsigned* p, unsigned v) { return __hip_atomic_fetch_add(p, v, __ATOMIC_RELAXED, __HIP_MEMORY_SCOPE_AGENT); }
__device__ __forceinline__ unsigned xb_xcc_id() { return (unsigned)__builtin_amdgcn_s_getreg((3 << 11) | 20) & 0xFu; }
#define XB_SPIN(cond, bar) do { unsigned _sp = 0; while (cond) { __builtin_amdgcn_s_sleep(1); \
    if ((++_sp & 255u) == 0u) { if (xb_ld(&(bar)[XB_TMO])) break; if (_sp > XB_SPIN_CAP) { atomicAdd(&(bar)[XB_TMO], 1u); break; } } } } while (0)

struct XcdBarrier {
    unsigned* bar; unsigned x;
    volatile LAS unsigned* st;
};

__device__ __forceinline__ XcdBarrier xcd_barrier_post(unsigned* bar, volatile LAS unsigned* st) {
    XcdBarrier b; b.bar = bar; b.x = xb_xcc_id(); b.st = st;
    if (threadIdx.x == 0) (void)xb_add(&bar[XB_XCNT(b.x)], 1u);
    return b;
}
__device__ __forceinline__ void xcd_barrier_complete(unsigned* bar, unsigned x, unsigned& nloc, unsigned& nx) {
    const unsigned G = gridDim.x * gridDim.y * gridDim.z;
    unsigned sum, cnt, mine, sp = 0u;
    for (;;) {
        sum = 0u; cnt = 0u; mine = 0u;
#pragma unroll
        for (unsigned j = 0; j < 16; ++j) { const unsigned c = xb_ld(&bar[XB_XCNT(j)]); sum += c; cnt += (c > 0u) ? 1u : 0u; mine = (j == x) ? c : mine; }
        if (sum == G) break;
        __builtin_amdgcn_s_sleep(1);
        if ((++sp & 255u) == 0u) { if (xb_ld(&bar[XB_TMO])) break; if (sp > XB_SPIN_CAP) { atomicAdd(&bar[XB_TMO], 1u); break; } }
    }
    nloc = mine > 0u ? mine : 1u; nx = cnt > 0u ? cnt : 1u;
}

__device__ __forceinline__ void xcd_barrier(const XcdBarrier& b) {
    asm volatile("s_waitcnt vmcnt(0)" ::: "memory");
    __syncthreads();
    if (threadIdx.x == 0) {
        unsigned* bar = b.bar;
        __builtin_amdgcn_s_waitcnt(0);
        unsigned nloc = b.st[0], nx = b.st[1];
        if (nloc == 0u) { xcd_barrier_complete(bar, b.x, nloc, nx); b.st[0] = nloc; b.st[1] = nx; }
        const unsigned old = xb_add(&bar[XB_XSUB(b.x)], 1u);
        const unsigned gen = old / nloc;
        if (old + 1u == (gen + 1u) * nloc) {
            __builtin_amdgcn_fence(__ATOMIC_RELEASE, "agent");
            asm volatile("s_waitcnt vmcnt(0)" ::: "memory");
            const unsigned og = xb_add(&bar[XB_TOP], 1u);
            const unsigned tg = og / nx;
            if (og + 1u == (tg + 1u) * nx) xb_add(&bar[XB_TOPGEN], 1u);
            else XB_SPIN(xb_ld(&bar[XB_TOPGEN]) == tg, bar);
            __builtin_amdgcn_fence(__ATOMIC_ACQUIRE, "agent");
            xb_add(&bar[XB_XGEN(b.x)], 1u);
            asm volatile("s_waitcnt vmcnt(0)" ::: "memory");
        } else {
            XB_SPIN(xb_ld(&bar[XB_XGEN(b.x)]) == gen, bar);
            __builtin_amdgcn_fence(__ATOMIC_ACQUIRE, "agent");
            asm volatile("s_waitcnt vmcnt(0)" ::: "memory");
        }
    }
    __syncthreads();
}

constexpr int CTL_WORDS = CTL_BAR_WORD + XCD_BAR_WORDS;
struct Args { const float* in[20]; float* out; unsigned char* ws; int ph_lo, ph_hi; };

typedef const Args __attribute__((address_space(4)))* KArgsP;
#ifndef DEFER_L1
#define DEFER_L1 1
#endif
__device__ __forceinline__ TrJob make_job(KArgsP a, unsigned char* ws, int l, int j) {
    unsigned char* wl = ws + WS_W + (size_t)l * LAYER_W;
    const int i0 = j == 0 ? 3 : j == 1 ? 5 : j == 2 ? 7 : j == 3 ? 9 : j == 4 ? 11 : j == 5 ? 14 : j == 6 ? 16 : 18;
    const int ig = j == 0 ? 2 : j == 2 ? 6 : j == 3 ? 8 : j == 4 ? 10 : j == 6 ? 15 : -1;
    const int K = (j == 1 || j == 7) ? DFF : j == 3 ? 512 : j == 4 ? 256 : DM;
    const int Nsrc = (j == 0 || j == 6) ? DFF : j == 2 ? NIN_SRC : j == 3 ? 1536 : DM;
    const int Ndst = (j == 0 || j == 6) ? NGU : j == 2 ? NIN : j == 3 ? 1536 : DM;
    const int kind = (j == 0 || j == 6) ? MAP_GU : j == 2 ? MAP_WIN : j == 3 ? MAP_QB : j == 4 ? MAP_KVB : MAP_ID;
    const size_t lwo = j == 0 ? LW_GU1 : j == 1 ? LW_D1 : j == 2 ? LW_IN : j == 3 ? LW_QB : j == 4 ? LW_KV : j == 5 ? LW_OUT : j == 6 ? LW_GU2 : LW_D2;
    TrJob J;
    J.W0 = a->in[i0] + (size_t)l * K * Nsrc; J.W1 = (j == 0 || j == 6) ? a->in[i0 + 1] + (size_t)l * K * Nsrc : nullptr;
    J.gain = ig >= 0 ? a->in[ig >= 0 ? ig : 0] + l * K : nullptr; J.WT = (bf16_t*)(wl + lwo); J.K = K; J.Nsrc = Nsrc; J.Ndst = Ndst; J.kind = kind;
    return J;
}
constexpr int TRN[8] = {(NGU / 64) * (DM / 64), (DM / 64) * (DFF / 64), (NIN / 64) * (DM / 64), (1536 / 64) * (512 / 64), (2048 / 64) * (256 / 64), (DM / 64) * (DM / 64), (NGU / 64) * (DM / 64), (DM / 64) * (DFF / 64)};
constexpr int NTR = TRN[0] + TRN[1] + TRN[2] + TRN[3] + TRN[4] + TRN[5] + TRN[6] + TRN[7];
constexpr int CV_PER_WAVE = 9, CV_PER_ITEM = 8 * CV_PER_WAVE, NCV = (NTR + CV_PER_ITEM - 1) / CV_PER_ITEM;
__device__ __forceinline__ void conv_item(KArgsP a, unsigned char* ws, int c, LAS unsigned char* lds) {
    int tid_l = threadIdx.x; asm volatile("" : "+v"(tid_l)); const int tid = tid_l, lane = tid & 63, wave = __builtin_amdgcn_readfirstlane(tid >> 6);
    LAS float* scr = (LAS float*)(lds + wave * 16640);
#pragma nounroll
    for (int k = 0; k < CV_PER_WAVE; ++k) {
        int t = c * CV_PER_ITEM + wave * CV_PER_WAVE + k;
        if (t >= NTR) break;
        int j = 0;
#pragma unroll
        for (int q = 0; q < 7; ++q) if (j == q && t >= TRN[q]) { t -= TRN[q]; j = q + 1; }
        const TrJob J = make_job(a, ws, 1, j);
        tr_item(J, scr, t, lane);
    }
}
__device__ __forceinline__ void prep_phase(KArgsP a, LAS unsigned char* lds) {
    int tid_l = threadIdx.x; asm volatile("" : "+v"(tid_l)); const int tid = tid_l, lane = tid & 63, wave = tid >> 6;
    const int gw = blockIdx.x * 8 + wave, NGW = gridDim.x * 8;
    unsigned char* ws = a->ws;
    if (blockIdx.x == 0) for (int i = tid; i < CTL_WORDS; i += 512) ((unsigned*)(ws + WS_CTL))[i] = 0u;
    LAS float* scr = (LAS float*)(lds + wave * 16640);
#pragma nounroll
    for (int l = 0; l < (DEFER_L1 ? 1 : DEPTH); ++l) {
#pragma nounroll
        for (int j = 0; j < 8; ++j) {
            const TrJob J = make_job(a, ws, l, j);
            const int nitems = (J.Ndst / 64) * (J.K / 64);
            for (int it = gw; it < nitems; it += NGW) tr_item(J, scr, it, lane);
        }
    }
    const float* x = a->in[0]; bf16_t* XB = (bf16_t*)(ws + WS_XB); float* SS = (float*)(ws + WS_SS);
    for (int m = gw; m < M; m += NGW) {
        const f32x4* xr = (const f32x4*)(x + (size_t)m * DM) + lane; float s = 0.f;
        unsigned long long* o8 = (unsigned long long*)(XB + (size_t)m * DM) + lane;
#pragma unroll
        for (int j = 0; j < 8; ++j) { const f32x4 v = xr[64 * j]; s += (v[0] * v[0] + v[1] * v[1]) + (v[2] * v[2] + v[3] * v[3]);
            o8[64 * j] = (unsigned long long)pk2(v[0], v[1]) | ((unsigned long long)pk2(v[2], v[3]) << 32); }
        s = wave_sum(s);
        if (lane < 32) SS[(size_t)m * 32 + lane] = lane == 0 ? s : 0.f;
    }
    const int* pos = (const int*)a->in[1]; f32x2* ROPE = (f32x2*)(ws + WS_ROPE);
    for (int e = blockIdx.x * 512 + tid; e < M * 32; e += gridDim.x * 512) {
        const int m = e >> 5, i = e & 31;
        const unsigned long long u = (unsigned long long)(long long)pos[m] * ROPE_F[i];
        const float y = (float)(int)(u >> 32) * (0.25f * 6.283185307179586f / 4294967296.0f), y2 = y * y;
        float sn = y * (1.0f + y2 * (-1.0f / 6 + y2 * (1.0f / 120 + y2 * (-1.0f / 5040 + y2 * (1.0f / 362880)))));
        float cs = 1.0f + y2 * (-0.5f + y2 * (1.0f / 24 + y2 * (-1.0f / 720 + y2 * (1.0f / 40320 + y2 * (-1.0f / 3628800)))));
        const float s2 = 2.0f * sn * cs, c2 = 1.0f - 2.0f * sn * sn; sn = 2.0f * s2 * c2; cs = 1.0f - 2.0f * s2 * s2;
        ROPE[e] = (f32x2){(float)cs, (float)sn};
    }
}

__device__ __forceinline__ void scan_phase(const MixBufs& B, LAS unsigned char* lds) {
    int tid_l = threadIdx.x; asm volatile("" : "+v"(tid_l)); const int tid = tid_l, lane = tid & 63, wave = tid >> 6;
    LAS float* wt = (LAS float*)(lds + LDS_X);
    for (int item = blockIdx.x; item < 256; item += gridDim.x) {
        const int seq = item >> 4, chunk = item & 15, b = seq >> 3, h = seq & 7;
        const size_t tok = (size_t)b * SEQ + chunk * 512 + tid;
        float v = mLOGF(B)[tok * 8 + h];
#pragma unroll
        for (int o = 1; o < 64; o <<= 1) { const float t = __shfl_up(v, o); if (lane >= o) v += t; }
        if (lane == 63) wt[wave] = v;
        __syncthreads();
        float pre = 0.f;
        for (int w = 0; w < wave; ++w) pre += wt[w];
        v += pre;
        mCUM(B)[tok * 8 + h] = v;
        if (tid == 511) mCHS(B)[seq * 16 + chunk] = v;
        float k2 = 0.f;
        { const u32x4* kr = (const u32x4*)(mKF(B) + tok * 512 + h * 64);
#pragma unroll
          for (int j = 0; j < 8; ++j) { const u32x4 w = kr[j];
#pragma unroll
              for (int e = 0; e < 4; ++e) { const float lo = __uint_as_float(w[e] << 16), hi2 = __uint_as_float(w[e] & 0xffff0000u); k2 += lo * lo + hi2 * hi2; } } }
#pragma unroll
        for (int o = 1; o < 64; o <<= 1) k2 = fmaxf(k2, __shfl_xor(k2, o));
        __syncthreads();
        if (lane == 0) wt[wave] = k2;
        __syncthreads();
        if (tid == 0) { float mxk = wt[0]; for (int w = 1; w < 8; ++w) mxk = fmaxf(mxk, wt[w]); mKNM(B)[seq * 16 + chunk] = mxk; }
        __syncthreads();
    }
}

#define MFMA32(a, b, c) __builtin_amdgcn_mfma_f32_32x32x16_bf16((a), (b), (c), 0, 0, 0)
__device__ __forceinline__ bf16x8 packp(const f32x16& p, int s) {
    u32x4 w; w[0] = pk2(p[8 * s], p[8 * s + 1]); w[1] = pk2(p[8 * s + 2], p[8 * s + 3]); w[2] = pk2(p[8 * s + 4], p[8 * s + 5]); w[3] = pk2(p[8 * s + 6], p[8 * s + 7]);
    return __builtin_bit_cast(bf16x8, w);
}
template <int DQ, int DK1, int DV, int MODE>
__device__ __forceinline__ void attn_item(const bf16_t* Qp, int ldq, const bf16_t* K1, int ldk1, const bf16_t* K2, const bf16_t* Vp, int ldv, bf16_t* Op,
                                          const float* CUM, const float* CHS, int h, float sink2, int b, int qb, LAS unsigned char* lds) {
    constexpr int KS = DQ * 2 + 16, VS = DV * 2 + 64, KBYTES = 64 * KS, VBYTES = 64 * VS;
    constexpr int OFF_K = 0, OFF_V = 2 * KBYTES, OFF_CK = OFF_V + 2 * VBYTES, OFF_PRE = OFF_CK + 512;
    static_assert(KS % 16 == 0 && VS % 16 == 0 && OFF_PRE + 256 <= LDS_X, "attention staging geometry");
    int tid_l = threadIdx.x; asm volatile("" : "+v"(tid_l));
    const int tid = tid_l, lane = tid & 63, wave = __builtin_amdgcn_readfirstlane(tid >> 6), r32 = lane & 31, hi = lane >> 5;
    const size_t tok0 = (size_t)b * SEQ;
    const int q0 = qb * 256, q0w = q0 + wave * 32, qpos = q0w + r32;
    LAS float* PRE = (LAS float*)(lds + OFF_PRE);
    int kt0 = 0; const int kt1 = 4 * (qb + 1);
    if (MODE == 2) { kt0 = 4 * qb - 2; if (kt0 < 0) kt0 = 0; }
    float cq2 = 0.f, crefloc = 0.f;
    if (MODE == 1) {
        const int cq = qb >> 1;
        if (tid == 0) { float acc = 0.f; PRE[cq] = 0.f; for (int c = cq - 1; c >= 0; --c) { acc -= CHS[(b * 8 + h) * 16 + c]; PRE[c] = acc; } }
        crefloc = CUM[(tok0 + q0) * 8 + h];
        cq2 = (CUM[(tok0 + qpos) * 8 + h] - crefloc) * LOG2E;
        __syncthreads();
    }
    bf16x8 qf[DQ / 16];
    { const bf16_t* qrow = Qp + (tok0 + qpos) * (size_t)ldq + hi * 8;
#pragma unroll
      for (int ks = 0; ks < DQ / 16; ++ks) qf[ks] = *(const bf16x8*)(qrow + ks * 16); }
    if (MODE == 1) {
        LAS float* WQ = (LAS float*)(lds + OFF_PRE + 64); LAS int* KT0 = (LAS int*)(lds + OFF_PRE + 128);
        float q2 = 0.f;
#pragma unroll
        for (int ks = 0; ks < DQ / 16; ++ks)
#pragma unroll
            for (int e = 0; e < 8; ++e) { const float x = __uint_as_float((unsigned)(unsigned short)qf[ks][e] << 16); q2 += x * x; }
        { auto rr = __builtin_amdgcn_permlane32_swap(__float_as_uint(q2), __float_as_uint(q2), false, false); q2 = __uint_as_float(rr[0]) + __uint_as_float(rr[1]); }
#pragma unroll
        for (int o = 1; o < 32; o <<= 1) q2 = fmaxf(q2, __shfl_xor(q2, o));
        if (lane == 0) WQ[wave] = q2;
        if (tid == 0) KT0[0] = 0;
        __syncthreads();
        float qm = WQ[0], km = CHS[256 + (b * 8 + h) * 16];
#pragma unroll
        for (int w = 1; w < 8; ++w) qm = fmaxf(qm, WQ[w]);
        for (int c = 1; c < 16; ++c) km = fmaxf(km, CHS[256 + (b * 8 + h) * 16 + c]);
        const float T = (150.0f + 1.0f + 2.02f * sqrtf(qm) * sqrtf(km)) * (1.0f / LOG2E);
        if (tid < 128) {
            bool skip = false;
            if (tid < 4 * qb) { const size_t sl = tok0 + (size_t)tid * 64 + 63; skip = ((CUM[sl * 8 + h] - crefloc) + PRE[tid >> 3]) >= T; }
            const unsigned long long bal = __builtin_amdgcn_ballot_w64(skip);
            const int lead = bal == ~0ull ? 64 : __builtin_ctzll(~bal);
            if (lane == 0) { if (wave == 0) { if (lead < 64) KT0[0] = lead; else KT0[0] = 64; } }
            __builtin_amdgcn_s_waitcnt(0);
            if (wave == 1 && lane == 0) WQ[8] = (float)lead;
        }
        __syncthreads();
        { int k0s = KT0[0]; if (k0s == 64) k0s = 64 + (int)WQ[8]; kt0 = k0s; }
        __syncthreads();
    }
    float ckreg = 0.f;
    constexpr int KCH = KS / 16, KDAT = DQ / 8, VCH = VS / 16, VDAT = DV / 8;
    auto dma_k = [&](int kt, int buf) {
        const bf16_t* k1t = K1 + (tok0 + (size_t)kt * 64) * (size_t)ldk1; const bf16_t* k2t = K2 + (tok0 + (size_t)kt * 64) * (size_t)(DQ - DK1);
#pragma unroll
        for (int j = 0; j < (KCH + 7) / 8; ++j) { const int i = j * 8 + wave;
            if (i < KCH) { const int c = i * 64 + lane, row = c / KCH; int ch = c - row * KCH; if (ch >= KDAT) ch = KDAT - 1;
                const bf16_t* src = (DK1 == DQ || ch * 8 < DK1) ? k1t + (unsigned)(row * ldk1 + ch * 8) : k2t + (unsigned)(row * (DQ - DK1) + (ch * 8 - DK1));
                __builtin_amdgcn_global_load_lds((const unsigned*)src, (LAS unsigned*)(lds + OFF_K + buf * KBYTES + i * 1024), 16, 0, 0); } }
    };
    auto dma_v = [&](int kt, int buf) {
        const bf16_t* vt = Vp + (tok0 + (size_t)kt * 64) * (size_t)ldv;
#pragma unroll
        for (int j = 0; j < (VCH + 7) / 8; ++j) { const int i = j * 8 + wave;
            if (i < VCH) { const int c = i * 64 + lane, row = c / VCH; int ch = c - row * VCH; if (ch >= VDAT) ch = VDAT - 1;
                __builtin_amdgcn_global_load_lds((const unsigned*)(vt + (unsigned)(row * ldv + ch * 8)), (LAS unsigned*)(lds + OFF_V + buf * VBYTES + i * 1024), 16, 0, 0); } }
        if (MODE == 1 && tid < 64) ckreg = ((CUM[(tok0 + (size_t)kt * 64 + tid) * 8 + h] - crefloc) + PRE[kt >> 3]) * LOG2E;
    };
    auto store_ck = [&](int buf) { if (MODE == 1 && tid < 64) *(LAS float*)(lds + OFF_CK + buf * 256 + tid * 4) = ckreg; };
    auto qk = [&](int buf, f32x16& a0, f32x16& a1) {
#pragma unroll
        for (int i = 0; i < 16; ++i) { a0[i] = 0.f; a1[i] = 0.f; }
        const LAS unsigned char* kb = lds + OFF_K + buf * KBYTES + r32 * KS + hi * 16;
#pragma unroll
        for (int ks = 0; ks < DQ / 16; ++ks) {
            const bf16x8 k0 = *(const LAS bf16x8*)(kb + ks * 32), k1 = *(const LAS bf16x8*)(kb + 32 * KS + ks * 32);
            a0 = MFMA32(k0, qf[ks], a0); a1 = MFMA32(k1, qf[ks], a1);
        }
    };
    f32x16 o[DV / 32];
#pragma unroll
    for (int d = 0; d < DV / 32; ++d)
#pragma unroll
        for (int i = 0; i < 16; ++i) o[d][i] = 0.f;
    float m_run = -1e30f, l_run = 0.f;
    dma_k(kt0, 0); dma_v(kt0, 0); store_ck(0);
    if (kt0 + 1 < kt1) dma_k(kt0 + 1, 1);
    asm volatile("s_waitcnt vmcnt(0)" ::: "memory");
    __syncthreads();
    f32x16 p0, p1, n0, n1;
    qk(0, p0, p1);
    for (int kt = kt0; kt < kt1; ++kt) {
        const int cur = (kt - kt0) & 1; const bool more1 = kt + 1 < kt1, more2 = kt + 2 < kt1;
        if (more2) dma_k(kt + 2, cur);
        if (more1) dma_v(kt + 1, cur ^ 1);
        {
            if (MODE == 1) {
                const LAS float* ck = (const LAS float*)(lds + OFF_CK + cur * 256);
#pragma unroll
                for (int g = 0; g < 4; ++g) { const f32x4 c0 = *(const LAS f32x4*)(ck + 8 * g + 4 * hi), c1 = *(const LAS f32x4*)(ck + 32 + 8 * g + 4 * hi);
#pragma unroll
                    for (int i = 0; i < 4; ++i) { p0[4 * g + i] += cq2 - c0[i]; p1[4 * g + i] += cq2 - c1[i]; } }
            }
            const bool diag = (64 * kt + 63 > q0w) || (MODE == 2 && 64 * kt <= q0w + 31 - 128);
            if (diag) {
#pragma unroll
                for (int i = 0; i < 16; ++i) { const int key = 64 * kt + (i & 3) + 8 * (i >> 2) + 4 * hi;
                    bool ok0 = key <= qpos, ok1 = key + 32 <= qpos;
                    if (MODE == 2) { ok0 = ok0 && key > qpos - 128; ok1 = ok1 && key + 32 > qpos - 128; }
                    if (!ok0) p0[i] = -INFINITY; if (!ok1) p1[i] = -INFINITY; }
            }
        }
        float mn;
        {
            float ma = fmaxf(fmaxf(p0[0], p0[1]), p1[0]), mb = fmaxf(fmaxf(p0[2], p0[3]), p1[1]);
            ma = fmaxf(fmaxf(ma, p1[2]), p1[3]);
#pragma unroll
            for (int i = 4; i < 16; i += 4) { ma = fmaxf(fmaxf(ma, p0[i]), p0[i + 1]); mb = fmaxf(fmaxf(mb, p0[i + 2]), p0[i + 3]); ma = fmaxf(fmaxf(ma, p1[i]), p1[i + 1]); mb = fmaxf(fmaxf(mb, p1[i + 2]), p1[i + 3]); }
            float mx = fmaxf(ma, mb);
            { auto rr = __builtin_amdgcn_permlane32_swap(__float_as_uint(mx), __float_as_uint(mx), false, false); mx = fmaxf(__uint_as_float(rr[0]), __uint_as_float(rr[1])); }
            mn = fmaxf(m_run, mx);
            const float alpha = __builtin_amdgcn_exp2f(m_run - mn);
            const bool grew = mn > m_run; m_run = mn;
            l_run *= alpha;
            if (__builtin_amdgcn_ballot_w64(grew) != 0ull) {
#pragma unroll
                for (int d = 0; d < DV / 32; ++d) o[d] *= alpha;
            }
        }
        bf16x8 pf[4];
        {
            qk(cur ^ 1, n0, n1);
            float rs0 = 0.f, rs1 = 0.f;
#pragma unroll
            for (int i = 0; i < 16; ++i) { p0[i] = __builtin_amdgcn_exp2f(p0[i] - mn); p1[i] = __builtin_amdgcn_exp2f(p1[i] - mn); rs0 += p0[i]; rs1 += p1[i]; }
            l_run += rs0 + rs1;
            pf[0] = packp(p0, 0); pf[1] = packp(p0, 1); pf[2] = packp(p1, 0); pf[3] = packp(p1, 1);
            __builtin_amdgcn_sched_group_barrier(0x100, 4, 0);
#pragma unroll
            for (int i = 0; i < DQ / 8; ++i) {
                __builtin_amdgcn_sched_group_barrier(0x100, 1, 0);
                __builtin_amdgcn_sched_group_barrier(0x008, 1, 0);
                __builtin_amdgcn_sched_group_barrier(0x002, DQ == 192 ? 4 : 12, 0);
                __builtin_amdgcn_sched_group_barrier(0x400, DQ == 192 ? 3 : 8, 0);
            }
            asm volatile("" : "+v"(pf[0]), "+v"(pf[1]), "+v"(pf[2]), "+v"(pf[3]), "+v"(l_run));
        }
        {
            const LAS unsigned char* vb = lds + OFF_V + cur * VBYTES + (4 * hi + ((lane & 15) >> 2)) * VS + (16 * ((lane >> 4) & 1) + 4 * (lane & 3)) * 2;
#pragma unroll
            for (int d = 0; d < DV / 32; ++d)
#pragma unroll
                for (int kk = 0; kk < 4; ++kk) {
                    const v4i16_t lo = __builtin_amdgcn_ds_read_tr16_b64_v4i16((LAS v4i16_t*)(vb + (16 * kk) * VS + d * 64));
                    const v4i16_t hh = __builtin_amdgcn_ds_read_tr16_b64_v4i16((LAS v4i16_t*)(vb + (16 * kk + 8) * VS + d * 64));
                    const bf16x8 vf = {lo[0], lo[1], lo[2], lo[3], hh[0], hh[1], hh[2], hh[3]};
                    o[d] = MFMA32(vf, pf[kk], o[d]);
                    if (kk == 3) asm volatile("" ::: "memory");
                }
        }
        if (more1) store_ck(cur ^ 1);
        asm volatile("s_waitcnt vmcnt(0)" ::: "memory");
        __syncthreads();
        p0 = n0; p1 = n1;
    }
    float l; { auto rr = __builtin_amdgcn_permlane32_swap(__float_as_uint(l_run), __float_as_uint(l_run), false, false); l = __uint_as_float(rr[0]) + __uint_as_float(rr[1]); }
    if (MODE == 2) l += __builtin_amdgcn_exp2f(sink2 - m_run);
    const float inv = 1.0f / l;
    bf16_t* orow = Op + (tok0 + qpos) * (size_t)DM;
#pragma unroll
    for (int d = 0; d < DV / 32; ++d)
#pragma unroll
        for (int g = 0; g < 4; ++g) { u32x2 w; w[0] = pk2(o[d][4 * g] * inv, o[d][4 * g + 1] * inv); w[1] = pk2(o[d][4 * g + 2] * inv, o[d][4 * g + 3] * inv);
            *(u32x2*)(orow + 32 * d + 8 * g + 4 * hi) = w; }
}

__device__ __forceinline__ void final_phase(float* out, const bf16_t* XB, const float* SS, const float* g) {
    int tid_l = threadIdx.x; asm volatile("" : "+v"(tid_l)); const int tid = tid_l, lane = tid & 63, wave = tid >> 6;
    const int gw = blockIdx.x * 8 + wave, NGW = gridDim.x * 8;
    for (int m = gw; m < M; m += NGW) {
        const float rs = rsqrtf(sum_ss(SS + (size_t)m * 32, 8) * (1.0f / DM) + RMS_EPS);
        const u32x4* xr = (const u32x4*)(XB + (size_t)m * DM) + lane; f32x4* orow = (f32x4*)(out + (size_t)m * DM); const f32x4* gr = (const f32x4*)g;
#pragma unroll
        for (int j = 0; j < 4; ++j) { const u32x4 w = xr[64 * j]; const int c4 = (64 * j + lane) * 2;
            orow[c4] = bf_lo4(w) * rs * gr[c4]; orow[c4 + 1] = bf_hi4(w) * rs * gr[c4 + 1]; }
    }
}

#ifndef PH_MASK
#define PH_MASK 255
#endif
constexpr int N_STEPS = 22;
__device__ __forceinline__ void attn_phase(KArgsP ka, unsigned char* ws, const float* sinks, int l, int cidx, LAS unsigned char* lds) {
    LAS int* slot = (LAS int*)(lds + LDS_X + 1024);
    unsigned* counter = (unsigned*)(ws + WS_CTL) + cidx;
    const MixBufs B{ws + WS_U};
    int tid_l = threadIdx.x; asm volatile("" : "+v"(tid_l)); const int tid = tid_l;
    for (;;) {
        __syncthreads();
        if (tid == 0) *slot = (int)atomicAdd(counter, 1u);
        __syncthreads();
        int idx = *slot;
        if (DEFER_L1 && l == 0) {
            if (idx >= 6 * NCV + (1536 - 5 * NCV)) break;
            if (idx < 6 * NCV) { const int g = idx / 6, pos = idx - 6 * g; if (pos == 5) { conv_item(ka, ws, g, lds); continue; } idx = 5 * g + pos; }
            else idx = 5 * NCV + (idx - 6 * NCV);
        }
        if (idx >= 1536) break;
        const int kind = idx >> 9, r = idx & 511, qb = 31 - (r >> 4), bh = r & 15, b = bh >> 3, h = bh & 7;
#if PH_MASK & 64
        if (kind == 0)
            attn_item<192, 128, 128, 0>(mQM(B) + h * 192, 1536, mKM(B) + h * 128, 1024, mKPE(B), mVM(B) + h * 128, 1024, mMIX(B) + h * 128, nullptr, nullptr, h, 0.f, b, qb, lds);
        else
#endif
        if (kind == 1)
            attn_item<64, 64, 64, 1>(mQF(B) + h * 64, 512, mKF(B) + h * 64, 512, nullptr, mVF(B) + h * 64, 512, mMIX(B) + 1536 + h * 64, mCUM(B), mCHS(B), h, 0.f, b, qb, lds);
        else
            attn_item<64, 64, 64, 2>(mQS(B) + h * 64, 512, mKS(B) + (h >> 2) * 64, 128, nullptr, mVS(B) + (h >> 2) * 64, 128, mMIX(B) + 1024 + h * 64, nullptr, nullptr, h, sinks[h] * LOG2E, b, qb, lds);
    }
}
__device__ __forceinline__ bool probe_rep(int st) {
#if defined(PROBE_MASK) && PROBE_MASK
    if (st == 0) return (PROBE_MASK >> 10) & 1;
    if (st >= N_STEPS - 1) return false;
    const int l = (st - 1) / 10, s = (st - 1) - 10 * l;
    if (s == 1 && l != 0) return false;
    return (PROBE_MASK >> s) & 1;
#else
    return false;
#endif
}
__global__ void __launch_bounds__(512, 2) mega_fwd(Args a) {
    extern __shared__ __attribute__((aligned(16))) unsigned char lds_raw[];
    LAS unsigned char* lds = (LAS unsigned char*)lds_raw;
    cg::grid_group grid = cg::this_grid();
    typedef const Args __attribute__((address_space(4)))* KArgs;
    const int ph_lo = a.ph_lo, ph_hi = a.ph_hi;
    int rep = 0; bool xb_posted = false;
    if (threadIdx.x < 2) ((LAS unsigned*)(lds + LDS_X + 2048))[threadIdx.x] = 0u;
    __syncthreads();
#pragma nounroll
    for (int st = ph_lo; st < ph_hi; (PROBE_MASK != 0 && rep == 0 && probe_rep(st)) ? (rep = 1) : (rep = 0, ++st)) {
        const int l = (st - 1) / 10, s = (st - 1) - 10 * l;
        const bool is_layer = st > 0 && st < N_STEPS - 1;
        KArgs ka = (KArgs)__builtin_amdgcn_kernarg_segment_ptr(); asm volatile("" : "+s"(ka));
        unsigned char* ws = ka->ws;
        if (st > ph_lo && !(is_layer && s == 4)) {
            XcdBarrier xb_; xb_.bar = (unsigned*)(ws + WS_CTL) + CTL_BAR_WORD; xb_.x = xb_xcc_id(); xb_.st = (volatile LAS unsigned*)(lds + LDS_X + 2048);
            if (!xb_posted) { grid.sync(); (void)xcd_barrier_post(xb_.bar, xb_.st); xb_posted = true; }
            else xcd_barrier(xb_);
        }
#if PH_MASK & 1
        if (st == 0) { prep_phase(ka, lds); continue; }
#endif
#if PH_MASK & 2
        if (st == N_STEPS - 1) { final_phase(ka->out, (const bf16_t*)(ws + WS_XB), (const float*)(ws + WS_SS), ka->in[19]); continue; }
#endif
        if (!is_layer) continue;
#if PH_MASK & 4
        if (s == 5) { scan_phase(MixBufs{ws + WS_U}, lds); continue; }
#endif
#if PH_MASK & 8
        if (s == 6) { attn_phase(ka, ws, ka->in[12] + l * 8, l, l + 2 * rep, lds); continue; }
#endif
#if PH_MASK & 16
        if (s == 5 || s == 6) continue;
        const int cb = blockIdx.x; int sub_g = gridDim.x, sub_c = cb;
        const bool split_ok = gridDim.x >= 128;
        unsigned char* wl = ws + WS_W + (size_t)l * LAYER_W;
        pg8::Gemm g; EpiAny E; E.tbl = (LAS float*)(lds + LDS_X); E.ws_ = ws; E.base = nullptr; E.out = ka->out; E.alpha = 0.f; E.fbias = nullptr; E.pn_off = 0;
        const bf16_t* XB = (const bf16_t*)(ws + WS_XB); const bf16_t* HID = (const bf16_t*)(ws + WS_U + U_HID);
        switch (s) {
        case 0: g = pg8::Gemm{XB, (const bf16_t*)(wl + LW_GU1), M, NGU, DM, 0}; E.kind = EPI_SWIGLU; break;
        case 8: g = pg8::Gemm{XB, (const bf16_t*)(wl + LW_GU2), M, NGU, DM, 0}; E.kind = EPI_SWIGLU; break;
        case 1: g = pg8::Gemm{HID, (const bf16_t*)(wl + LW_D1), M, DM, DFF, 1}; E.kind = EPI_RESID; E.base = l == 0 ? ka->in[0] : (const float*)ka->out; E.alpha = 0.5f; break;
        case 9: g = pg8::Gemm{HID, (const bf16_t*)(wl + LW_D2), M, DM, DFF, 1}; E.kind = EPI_RESID; E.base = ka->out; E.alpha = 0.5f; break;
        case 7: g = pg8::Gemm{(const bf16_t*)(ws + WS_U + U_MIX), (const bf16_t*)(wl + LW_OUT), M, DM, DM, 0}; E.kind = EPI_RESID; E.base = ka->out; E.alpha = 1.0f; break;
        case 2: g = pg8::Gemm{XB, (const bf16_t*)(wl + LW_IN), M, split_ok ? NIN - 256 : NIN, DM, 0}; E.kind = EPI_WIN; E.fbias = ka->in[13] + l * 8; break;
        case 3:
            if (split_ok && cb < 64) { g = pg8::Gemm{XB, (const bf16_t*)(wl + LW_IN) + (size_t)(NIN - 256) * DM, M, 256, DM, 0}; E.kind = EPI_WIN; E.fbias = ka->in[13] + l * 8; E.pn_off = 12; sub_g = 64; }
            else { g = pg8::Gemm{(const bf16_t*)(ws + WS_U + U_CQ), (const bf16_t*)(wl + LW_QB), M, 1536, 512, 0}; E.kind = EPI_QB; if (split_ok) { sub_g = gridDim.x - 64; sub_c = cb - 64; } }
            break;
        default:
            if (split_ok && cb < 64) continue;
            g = pg8::Gemm{(const bf16_t*)(ws + WS_U + U_CKV), (const bf16_t*)(wl + LW_KV), M, 2048, 256, 0}; E.kind = EPI_KVB; if (split_ok) { sub_g = gridDim.x - 64; sub_c = cb - 64; }
            break;
        }
        pg8::StaticOrder S; S.init(g.M, g.N, sub_g, sub_c);
        pg8::gemm_phase<EpiAny, pg8::StaticOrder, true, true>(lds, g, S, E);
#endif
    }
#if defined(PROBE_SYNCS)
    for (int i = 0; i < PROBE_SYNCS; ++i) grid.sync();
#endif
}

#ifndef MK_PER_PHASE
#define MK_PER_PHASE 0
#endif
extern "C" void kernel_launch(void* const* d_in, const int* in_sizes, int n_in, void* d_out, int out_size, void* d_ws, size_t ws_size, hipStream_t stream) {
    static int grid = 0;
    if (grid == 0) {
        if (n_in != 20 || out_size != M * DM || ws_size < WS_END) { fprintf(stderr, "kernel_launch: unexpected shapes (n_in %d out %d ws %zu need %zu)\n", n_in, out_size, ws_size, (size_t)WS_END); grid = -1; return; }
        int dev = 0, cus = 0, per_cu = 0;
        hipGetDevice(&dev); hipDeviceGetAttribute(&cus, hipDeviceAttributeMultiprocessorCount, dev);
        if (hipFuncSetAttribute((const void*)mega_fwd, hipFuncAttributeMaxDynamicSharedMemorySize, LDS_BYTES) != hipSuccess) { fprintf(stderr, "kernel_launch: hipFuncSetAttribute failed\n"); grid = -1; return; }
        hipOccupancyMaxActiveBlocksPerMultiprocessor(&per_cu, (const void*)mega_fwd, 512, LDS_BYTES);
        if (per_cu < 1) per_cu = 1;
        grid = cus * per_cu;
    }
    if (grid < 0) return;
    Args a{};
    for (int i = 0; i < 20; ++i) a.in[i] = (const float*)d_in[i];
    a.out = (float*)d_out; a.ws = (unsigned char*)d_ws;
#if MK_PER_PHASE
    for (int ph = 0; ph < N_STEPS; ++ph) { a.ph_lo = ph; a.ph_hi = ph + 1; hipLaunchKernelGGL(mega_fwd, dim3(grid), dim3(512), LDS_BYTES, stream, a); }
#else
    a.ph_lo = 0; a.ph_hi = N_STEPS;
    void* args[] = {&a};
    hipError_t e = hipLaunchCooperativeKernel((const void*)mega_fwd, dim3(grid), dim3(512), args, LDS_BYTES, stream);
    if (e != hipSuccess) fprintf(stderr, "cooperative launch failed: %s (grid %d)\n", hipGetErrorString(e), grid);
#endif
}
```

```cpp
#include <hip/hip_runtime.h>
#include <hip/hip_cooperative_groups.h>
#include <cstdio>
#include <cstdint>
#include <cmath>
namespace cg = cooperative_groups;
namespace pg8 {
#define PG8_LAS __attribute__((address_space(3)))
typedef unsigned short bf16_t;
typedef short bf16x8 __attribute__((ext_vector_type(8)));
typedef float f32x4 __attribute__((ext_vector_type(4)));
typedef unsigned u32x4 __attribute__((ext_vector_type(4)));
constexpr int BM = 256, BK = 64, HALF = 128, HTB = HALF * BK * 2  , STAGE_BYTES = 8 * HTB, NXCD = 8, WGM = 8;

__host__ __device__ __forceinline__ int lds_byte(int r, int c) { const int st = (r >> 4) * 2 + (c >> 5), rr = r & 15, cc = c & 31, ob = rr * 64 + cc * 2; return st * 1024 + (ob ^ (((ob >> 9) & 1) << 5)); }
__host__ __device__ __forceinline__ void stage_rc(int b, int& R, int& C) { const int st = b / 1024, sb = b % 1024, swz = sb ^ (((sb >> 9) & 1) << 5); R = (st >> 1) * 16 + swz / 64; C = (st & 1) * 32 + (swz % 64) / 2; }
__host__ __device__ __forceinline__ int perm32(int rho) { const int n = rho >> 4, i = rho & 15; return 8 * (i >> 2) + 4 * n + (i & 3); }

struct Unit { int pm, pn; };
struct Gemm { const bf16_t* A; const bf16_t* Bt; int M, N, K; int atiled; };

struct StaticOrder {
    int nM, nN, nwg, G, c;
    __host__ __device__ void init(int M, int N, int G_, int c_) { nM = M / BM; nN = N / BM; nwg = nM * nN; G = G_; c = c_; }
    __host__ __device__ bool next(int i, Unit& u) const {
        const long L = (long)i * G + c; if (L >= nwg) return false;
        int wgid = (int)L; { const int q = nwg / NXCD, r = nwg % NXCD, xcd = wgid % NXCD, off = wgid / NXCD; wgid = (xcd < r ? xcd * (q + 1) : r * (q + 1) + (xcd - r) * q) + off; }
        const int nig = WGM * nN, gid = wgid / nig, fm = gid * WGM, gsz = (nM - fm) < WGM ? (nM - fm) : WGM;
        u.pm = fm + ((wgid % nig) % gsz); u.pn = (wgid % nig) / gsz; return true;
    }
    __device__ __forceinline__ void a_ready(const Unit&) const {}
    __device__ __forceinline__ void done(const Unit&) const {}
};
template <class Epi, class Sched, bool ALIGN_EPI = false, bool SP2 = false>
__device__ __forceinline__ void gemm_phase(PG8_LAS unsigned char* lds, const Gemm g, const Sched& S, const Epi& E) {
    int tid_l = threadIdx.x; asm volatile("" : "+v"(tid_l));
    const int tid = tid_l, wid = __builtin_amdgcn_readfirstlane(tid >> 6), lane = tid & 63, wr = wid >> 2, wc = wid & 3, fr = lane & 15, fq = lane >> 4;
    const int K = g.K, nt = K / BK;
    unsigned voffA[2], voffB[2];
#pragma unroll
    for (int i = 0; i < 2; ++i) { int R, C; stage_rc(tid * 16 + i * 8192, R, C); const int Rb = Epi::PERM ? ((R & ~31) + perm32(R & 31)) : R;
        voffA[i] = (unsigned)(R * (g.atiled ? 64 : K) + C) * 2u; voffB[i] = (unsigned)(Rb * 64 + C) * 2u; }
    const size_t kstepA = g.atiled ? (size_t)(BM * BK * 2) : (size_t)(BK * 2), kstepB = (size_t)(BM * BK * 2);
    const size_t hstepA = g.atiled ? (size_t)(HALF * BK * 2) : (size_t)HALF * K * 2, hstepB = (size_t)(HALF * BK * 2);
    const size_t tstepA = (size_t)BM * K * 2, tstepB = (size_t)BM * K * 2;
    const unsigned ldsw = (unsigned)wid * 1024u;
    const int aoff = lds_byte(wr * 64 + fr, fq * 8), boff = lds_byte(wc * 32 + fr, fq * 8);
#define PG8_SA(b, h) (((b) * 2 + (h)) * HTB)
#define PG8_SB(b, h) ((4 + (b) * 2 + (h)) * HTB)
#define PG8_STAGE(bufoff, gbase, voff) do { _Pragma("unroll") for (int _i = 0; _i < 2; ++_i) \
        __builtin_amdgcn_global_load_lds((const unsigned*)((const char*)(gbase) + (voff)[_i]), (PG8_LAS unsigned*)(lds + (bufoff) + ldsw + _i * 8192), 16, 0, 0); } while (0)
#define PG8_LDA(dst, b, h) do { _Pragma("unroll") for (int m = 0; m < 4; ++m) _Pragma("unroll") for (int k = 0; k < 2; ++k) dst[m][k] = *(const PG8_LAS bf16x8*)(lds + PG8_SA(b, h) + aoff + m * 2048 + k * 1024); } while (0)
#define PG8_LDB(dst, b, h) do { _Pragma("unroll") for (int n = 0; n < 2; ++n) _Pragma("unroll") for (int k = 0; k < 2; ++k) dst[n][k] = *(const PG8_LAS bf16x8*)(lds + PG8_SB(b, h) + boff + n * 2048 + k * 1024); } while (0)
#define PG8_MMA(ai, bj, At, Bt) do { __builtin_amdgcn_s_setprio(1); _Pragma("unroll") for (int m = 0; m < 4; ++m) _Pragma("unroll") for (int n = 0; n < 2; ++n) _Pragma("unroll") for (int k = 0; k < 2; ++k) \
        acc[ai][bj][m][n] = __builtin_amdgcn_mfma_f32_16x16x32_bf16(Bt[n][k], At[m][k], acc[ai][bj][m][n], 0, 0, 0); __builtin_amdgcn_s_setprio(0); } while (0)
#define PG8_WAIT_V(n) asm volatile("s_waitcnt vmcnt(" #n ")" ::: "memory")
#define PG8_WAIT_L(n) asm volatile("s_waitcnt lgkmcnt(" #n ")" ::: "memory")
#define PG8_BAR __builtin_amdgcn_s_barrier()
#define PG8_SCHED __builtin_amdgcn_sched_barrier(0)
    Unit cur, nxt; int ui = 0;
    if (!S.next(0, cur)) return;
    f32x4 acc[2][2][4][2];
#pragma unroll
    for (int a = 0; a < 2; ++a)
#pragma unroll
        for (int b = 0; b < 2; ++b)
#pragma unroll
            for (int m = 0; m < 4; ++m)
#pragma unroll
                for (int n = 0; n < 2; ++n) acc[a][b][m][n] = (f32x4){0.f, 0.f, 0.f, 0.f};
    bf16x8 At[4][2], B0[2][2], B1[2][2];
    const char* cA = (const char*)g.A + (size_t)cur.pm * tstepA; const char* cB = (const char*)g.Bt + (size_t)cur.pn * tstepB;
    S.a_ready(cur); E.prefetch(cur, 0, tid);
    if constexpr (SP2) {
        PG8_STAGE(PG8_SB(0, 0), cB, voffB); PG8_STAGE(PG8_SB(0, 1), cB + hstepB, voffB); PG8_STAGE(PG8_SA(0, 0), cA, voffA); PG8_STAGE(PG8_SA(0, 1), cA + hstepA, voffA);
        if (wr == 1) PG8_BAR;
        PG8_WAIT_V(2); PG8_BAR;
        PG8_STAGE(PG8_SB(1, 0), cB + kstepB, voffB); PG8_STAGE(PG8_SA(1, 0), cA + kstepA, voffA); PG8_STAGE(PG8_SB(1, 1), cB + hstepB + kstepB, voffB);
        PG8_WAIT_V(6); PG8_BAR;
    } else {
        PG8_STAGE(PG8_SB(0, 0), cB, voffB); PG8_STAGE(PG8_SA(0, 0), cA, voffA); PG8_STAGE(PG8_SB(0, 1), cB + hstepB, voffB); PG8_STAGE(PG8_SA(0, 1), cA + hstepA, voffA);
        if (wr == 1) PG8_BAR;
        PG8_WAIT_V(4); PG8_BAR;
        PG8_STAGE(PG8_SB(1, 0), cB + kstepB, voffB); PG8_STAGE(PG8_SA(1, 0), cA + kstepA, voffA); PG8_STAGE(PG8_SB(1, 1), cB + hstepB + kstepB, voffB);
        PG8_WAIT_V(6); PG8_BAR;
    }
    for (;;) {
        const bool has_next = S.next(ui + 1, nxt);
        const char* nA = has_next ? (const char*)g.A + (size_t)nxt.pm * tstepA : cA; const char* nB = has_next ? (const char*)g.Bt + (size_t)nxt.pn * tstepB : cB;
        for (int t = 0; t < nt; t += 2) {
            const bool last = (t == nt - 2);
            const char* a1 = cA + (size_t)(t + 1) * kstepA;
            const char* a2 = last ? nA : cA + (size_t)(t + 2) * kstepA; const char* b2 = last ? nB : cB + (size_t)(t + 2) * kstepB;
            const char* a3 = a2 + kstepA; const char* b3 = b2 + kstepB;
            if (last && has_next) { S.a_ready(nxt); E.prefetch(nxt, ui + 1, tid); }
            if constexpr (SP2) {
            PG8_LDB(B0, 0, 0); PG8_LDB(B1, 0, 1); PG8_SCHED; PG8_LDA(At, 0, 0); PG8_STAGE(PG8_SA(1, 1), a1 + hstepA, voffA);
            PG8_WAIT_V(8); PG8_WAIT_L(0); PG8_BAR; PG8_MMA(0, 0, At, B0); PG8_MMA(0, 1, At, B1); PG8_BAR; PG8_SCHED;
            PG8_LDA(At, 0, 1); PG8_STAGE(PG8_SB(0, 0), b2, voffB); PG8_STAGE(PG8_SB(0, 1), b2 + hstepB, voffB); PG8_STAGE(PG8_SA(0, 0), a2, voffA);
            PG8_WAIT_V(8); PG8_WAIT_L(0); PG8_BAR; PG8_MMA(1, 0, At, B0); PG8_MMA(1, 1, At, B1); PG8_BAR; PG8_SCHED;
            PG8_LDB(B0, 1, 0); PG8_LDB(B1, 1, 1); PG8_SCHED; PG8_LDA(At, 1, 0); PG8_STAGE(PG8_SA(0, 1), a2 + hstepA, voffA);
            PG8_WAIT_V(8); PG8_WAIT_L(0); PG8_BAR; PG8_MMA(0, 0, At, B0); PG8_MMA(0, 1, At, B1); PG8_BAR; PG8_SCHED;
            PG8_LDA(At, 1, 1); PG8_STAGE(PG8_SB(1, 0), b3, voffB); PG8_STAGE(PG8_SB(1, 1), b3 + hstepB, voffB); PG8_STAGE(PG8_SA(1, 0), a3, voffA);
            PG8_WAIT_V(8); PG8_WAIT_L(0); PG8_BAR; PG8_MMA(1, 0, At, B0); PG8_MMA(1, 1, At, B1); PG8_BAR; PG8_SCHED;
            } else {
            PG8_LDB(B0, 0, 0); PG8_SCHED; PG8_LDA(At, 0, 0); PG8_STAGE(PG8_SA(1, 1), a1 + hstepA, voffA);
            PG8_WAIT_L(8); PG8_BAR; PG8_WAIT_L(0); PG8_MMA(0, 0, At, B0); PG8_BAR; PG8_SCHED;
            PG8_LDB(B1, 0, 1); PG8_STAGE(PG8_SB(0, 0), b2, voffB);
            PG8_BAR; PG8_WAIT_L(0); PG8_MMA(0, 1, At, B1); PG8_BAR;
            PG8_LDA(At, 0, 1); PG8_STAGE(PG8_SA(0, 0), a2, voffA);
            PG8_BAR; PG8_WAIT_L(0); PG8_MMA(1, 0, At, B0); PG8_BAR; PG8_SCHED;
            PG8_STAGE(PG8_SB(0, 1), b2 + hstepB, voffB);
            PG8_WAIT_V(6); PG8_BAR; PG8_MMA(1, 1, At, B1); PG8_BAR;
            PG8_LDB(B0, 1, 0); PG8_SCHED; PG8_LDA(At, 1, 0); PG8_STAGE(PG8_SA(0, 1), a2 + hstepA, voffA);
            PG8_WAIT_L(8); PG8_BAR; PG8_WAIT_L(0); PG8_MMA(0, 0, At, B0); PG8_BAR; PG8_SCHED;
            PG8_LDB(B1, 1, 1); PG8_STAGE(PG8_SB(1, 0), b3, voffB);
            PG8_BAR; PG8_WAIT_L(0); PG8_MMA(0, 1, At, B1); PG8_BAR;
            PG8_LDA(At, 1, 1); PG8_STAGE(PG8_SA(1, 0), a3, voffA);
            PG8_BAR; PG8_WAIT_L(0); PG8_MMA(1, 0, At, B0); PG8_BAR; PG8_SCHED;
            PG8_STAGE(PG8_SB(1, 1), b3 + hstepB, voffB);
            PG8_WAIT_V(6); PG8_BAR; PG8_MMA(1, 1, At, B1); PG8_BAR;
            }
        }
        if constexpr (ALIGN_EPI) { if (wr == 0) PG8_BAR; }
        if constexpr (!Epi::AFTER_DRAIN) { E(acc, cur, wr, wc, fr, fq, ui); S.done(cur); }
        if (!has_next) break;
#pragma unroll
        for (int a = 0; a < 2; ++a)
#pragma unroll
            for (int b = 0; b < 2; ++b)
#pragma unroll
                for (int m = 0; m < 4; ++m)
#pragma unroll
                    for (int n = 0; n < 2; ++n) acc[a][b][m][n] = (f32x4){0.f, 0.f, 0.f, 0.f};
        cur = nxt; cA = nA; cB = nB; ++ui;
        if constexpr (ALIGN_EPI) { if (wr == 1) PG8_BAR; }
    }
    PG8_WAIT_V(0);
    if constexpr (!ALIGN_EPI) { if (wr == 0) PG8_BAR; }
    PG8_BAR;
    if constexpr (Epi::AFTER_DRAIN) { E.fused(acc, cur, wr, wc, fr, fq, lds, wid, lane); S.done(cur); }
#undef PG8_SA
#undef PG8_SB
#undef PG8_STAGE
#undef PG8_LDA
#undef PG8_LDB
#undef PG8_MMA
#undef PG8_WAIT_V
#undef PG8_WAIT_L
#undef PG8_BAR
#undef PG8_SCHED
}
}
#define LAS __attribute__((address_space(3)))
#ifndef PROBE_MASK
#define PROBE_MASK 0
#endif
using pg8::bf16_t; using pg8::bf16x8; using pg8::f32x4; using pg8::u32x4; using pg8::Unit;
typedef unsigned u32x2 __attribute__((ext_vector_type(2)));
typedef float f32x2 __attribute__((ext_vector_type(2)));
typedef float f32x16 __attribute__((ext_vector_type(16)));
typedef short v4i16_t __attribute__((ext_vector_type(4)));
typedef __bf16 bf16x2_t __attribute__((ext_vector_type(2)));

constexpr int M = 16384, SEQ = 8192, DM = 2048, DFF = 5632, NGU = 11264, NIN = 3328, DEPTH = 2;
constexpr int NIN_SRC = 3144;
constexpr float RMS_EPS = 1e-6f;
constexpr float LOG2E = 1.4426950408889634f;
constexpr float QSCALE_M = 0.07216878364870322f * LOG2E;
constexpr float QSCALE_64 = 0.125f * LOG2E;

constexpr size_t SZ_WGU = (size_t)NGU * DM * 2, SZ_WD = (size_t)DM * DFF * 2, SZ_WIN = (size_t)NIN * DM * 2, SZ_WQB = (size_t)1536 * 512 * 2,
                 SZ_WKV = (size_t)2048 * 256 * 2, SZ_WOUT = (size_t)2048 * 2048 * 2;
constexpr size_t LW_GU1 = 0, LW_D1 = LW_GU1 + SZ_WGU, LW_IN = LW_D1 + SZ_WD, LW_QB = LW_IN + SZ_WIN, LW_KV = LW_QB + SZ_WQB, LW_OUT = LW_KV + SZ_WKV,
                 LW_GU2 = LW_OUT + SZ_WOUT, LW_D2 = LW_GU2 + SZ_WGU, LAYER_W = LW_D2 + SZ_WD;
constexpr size_t WS_CTL = 0, WS_W = 1u << 20, WS_XB = WS_W + DEPTH * LAYER_W, WS_SS = WS_XB + (size_t)M * DM * 2, WS_ROPE = WS_SS + (size_t)M * 32 * 4,
                 WS_U = WS_ROPE + (size_t)M * 32 * 8;
constexpr size_t U_HID = 0;
constexpr size_t U_CQ = 0, U_CKV = U_CQ + (size_t)M * 512 * 2, U_SSQ = U_CKV + (size_t)M * 256 * 2, U_SSKV = U_SSQ + (size_t)M * 8 * 4, U_QS = U_SSKV + (size_t)M * 4 * 4,
                 U_KS = U_QS + (size_t)M * 512 * 2, U_VS = U_KS + (size_t)M * 128 * 2, U_KPE = U_VS + (size_t)M * 128 * 2, U_LOGF = U_KPE + (size_t)M * 64 * 2,
                 U_CUM = U_LOGF + (size_t)M * 8 * 4, U_CHS = U_CUM + (size_t)M * 8 * 4, U_QF = U_CHS + 4096, U_KF = U_QF + (size_t)M * 512 * 2, U_VF = U_KF + (size_t)M * 512 * 2,
                 U_QM = U_VF + (size_t)M * 512 * 2, U_KM = U_QM + (size_t)M * 1536 * 2, U_VM = U_KM + (size_t)M * 1024 * 2, U_MIX = U_VM + (size_t)M * 1024 * 2,
                 U_END_MIX = U_MIX + (size_t)M * 2048 * 2;
constexpr size_t U_BYTES = (U_END_MIX > (size_t)M * DFF * 2) ? U_END_MIX : (size_t)M * DFF * 2;
constexpr size_t WS_END = WS_U + U_BYTES;
constexpr int LDS_BYTES = 131072 + 4096;
constexpr int LDS_X = 131072;

__device__ __forceinline__ unsigned f2bf(float f) { unsigned u = __builtin_bit_cast(unsigned, f); return (u + 0x7fffu + ((u >> 16) & 1u)) >> 16; }
__device__ __forceinline__ unsigned pk2(float lo, float hi) { f32x2 v = {lo, hi}; bf16x2_t b = __builtin_convertvector(v, bf16x2_t); return __builtin_bit_cast(unsigned, b); }
__device__ __forceinline__ float wave_sum(float v) {
#pragma unroll
    for (int o = 1; o < 64; o <<= 1) v += __shfl_xor(v, o);
    return v;
}
__device__ __forceinline__ float sum_ss(const float* p, int n4) {
    f32x4 s = {0.f, 0.f, 0.f, 0.f};
    for (int i = 0; i < n4; ++i) s += *(const f32x4*)(p + 4 * i);
    return (s[0] + s[1]) + (s[2] + s[3]);
}

struct MixBufs { unsigned char* U; };
#define MB_BF(name, off) __device__ __forceinline__ bf16_t* name(const MixBufs& b) { return (bf16_t*)(b.U + (off)); }
#define MB_F32(name, off) __device__ __forceinline__ float* name(const MixBufs& b) { return (float*)(b.U + (off)); }
MB_BF(mCQ, U_CQ) MB_BF(mCKV, U_CKV) MB_BF(mQS, U_QS) MB_BF(mKS, U_KS) MB_BF(mVS, U_VS) MB_BF(mKPE, U_KPE) MB_BF(mQF, U_QF) MB_BF(mKF, U_KF) MB_BF(mVF, U_VF)
MB_BF(mQM, U_QM) MB_BF(mKM, U_KM) MB_BF(mVM, U_VM) MB_BF(mMIX, U_MIX) MB_F32(mSSQ, U_SSQ) MB_F32(mSSKV, U_SSKV) MB_F32(mLOGF, U_LOGF) MB_F32(mCUM, U_CUM) MB_F32(mCHS, U_CHS) MB_F32(mKNM, U_CHS + 1024)
#define EPI_ROW(it) (u.pm * 256 + ((it) >> 2) * 128 + wr * 64 + ((it) & 3) * 16 + fr)
#define EPI_LROW(it) (((it) >> 2) * 128 + wr * 64 + ((it) & 3) * 16 + fr)
__device__ __forceinline__ int opaque(int r) { asm volatile("" : "+v"(r)); return r; }
__device__ __forceinline__ u32x4 pack8(const f32x4& a, const f32x4& b, float sc) { u32x4 w; w[0] = pk2(a[0] * sc, a[1] * sc); w[1] = pk2(a[2] * sc, a[3] * sc); w[2] = pk2(b[0] * sc, b[1] * sc); w[3] = pk2(b[2] * sc, b[3] * sc); return w; }
__device__ __forceinline__ float sq8(const f32x4& a, const f32x4& b, float sc) { float q = 0.f;
#pragma unroll
    for (int i = 0; i < 4; ++i) { const float x = a[i] * sc, y = b[i] * sc; q += x * x + y * y; } return q; }
struct Rope8 { f32x4 t[4]; };
__device__ __forceinline__ void rope_load(Rope8& R, const f32x2* ROPE, int r, int dd0) { const f32x4* p = (const f32x4*)(ROPE + (size_t)r * 32 + dd0);
#pragma unroll
    for (int i = 0; i < 4; ++i) R.t[i] = p[i]; }
__device__ __forceinline__ void rope8(const f32x4 (&a1)[2], const f32x4 (&a2)[2], float sc, const Rope8& R, u32x4& w1, u32x4& w2) {
    float o1[8], o2[8];
#pragma unroll
    for (int n = 0; n < 2; ++n) {
        const f32x4 t0 = R.t[2 * n], t1 = R.t[2 * n + 1];
        const float c[4] = {t0[0], t0[2], t1[0], t1[2]}, s[4] = {t0[1], t0[3], t1[1], t1[3]};
#pragma unroll
        for (int i = 0; i < 4; ++i) { const float x1 = a1[n][i] * sc, x2 = a2[n][i] * sc; o1[4 * n + i] = x1 * c[i] - x2 * s[i]; o2[4 * n + i] = x2 * c[i] + x1 * s[i]; }
    }
    w1[0] = pk2(o1[0], o1[1]); w1[1] = pk2(o1[2], o1[3]); w1[2] = pk2(o1[4], o1[5]); w1[3] = pk2(o1[6], o1[7]);
    w2[0] = pk2(o2[0], o2[1]); w2[1] = pk2(o2[2], o2[3]); w2[2] = pk2(o2[4], o2[5]); w2[3] = pk2(o2[6], o2[7]);
}
__device__ __forceinline__ void epi_swiglu(bf16_t* H, const LAS float* tbl, const f32x4 (&acc)[2][2][4][2], const Unit& u, int wr, int wc, int fr, int fq) {
    const int col0 = u.pn * 128 + wc * 32 + fq * 8;
#pragma unroll
    for (int it = 0; it < 8; ++it) {
        const int ai = it >> 2, m = it & 3; const int r = opaque(EPI_ROW(it));
        const float rs = tbl[EPI_LROW(it)];
        u32x4 w;
#pragma unroll
        for (int n = 0; n < 2; ++n) {
            const f32x4 g = acc[ai][0][m][n] * rs, up = acc[ai][1][m][n] * rs; float hv[4];
#pragma unroll
            for (int i = 0; i < 4; ++i) hv[i] = g[i] * __builtin_amdgcn_rcpf(1.0f + __expf(-g[i])) * up[i];
            w[2 * n] = pk2(hv[0], hv[1]); w[2 * n + 1] = pk2(hv[2], hv[3]);
        }
        *(u32x4*)(H + ((size_t)(r >> 8) * (DFF / 64) + (col0 >> 6)) * 16384 + (r & 255) * 64 + (col0 & 63)) = w;
    }
}
__device__ __forceinline__ f32x4 bf_lo4(const u32x4& w) { return (f32x4){__uint_as_float(w[0] << 16), __uint_as_float(w[0] & 0xffff0000u), __uint_as_float(w[1] << 16), __uint_as_float(w[1] & 0xffff0000u)}; }
__device__ __forceinline__ f32x4 bf_hi4(const u32x4& w) { return (f32x4){__uint_as_float(w[2] << 16), __uint_as_float(w[2] & 0xffff0000u), __uint_as_float(w[3] << 16), __uint_as_float(w[3] & 0xffff0000u)}; }
__device__ __forceinline__ void epi_resid(bf16_t* XB, float* SS, float alpha, const f32x4 (&acc)[2][2][4][2], const Unit& u, int wr, int wc, int fr, int fq) {
    const int c0 = u.pn * 256 + wc * 32 + fq * 8;
    u32x4 pre[2][2];
    { const bf16_t* p = XB + (size_t)opaque(EPI_ROW(0)) * DM + c0; pre[0][0] = *(const u32x4*)p; pre[0][1] = *(const u32x4*)(p + 128); }
#pragma unroll
    for (int it = 0; it < 8; ++it) {
        const int ai = it >> 2, m = it & 3; const int r = opaque(EPI_ROW(it));
        if (it + 1 < 8) { const bf16_t* p = XB + (size_t)opaque(EPI_ROW(it + 1)) * DM + c0; pre[(it + 1) & 1][0] = *(const u32x4*)p; pre[(it + 1) & 1][1] = *(const u32x4*)(p + 128); }
        float q = 0.f;
#pragma unroll
        for (int bj = 0; bj < 2; ++bj) {
            const size_t off = (size_t)r * DM + c0 + bj * 128;
            const u32x4 bw = pre[it & 1][bj];
            const f32x4 o0 = bf_lo4(bw) + acc[ai][bj][m][0] * alpha, o1 = bf_hi4(bw) + acc[ai][bj][m][1] * alpha;
            u32x4 w; w[0] = pk2(o0[0], o0[1]); w[1] = pk2(o0[2], o0[3]); w[2] = pk2(o1[0], o1[1]); w[3] = pk2(o1[2], o1[3]);
            *(u32x4*)(XB + off) = w;
            q += (o0[0] * o0[0] + o0[1] * o0[1]) + (o0[2] * o0[2] + o0[3] * o0[3]) + (o1[0] * o1[0] + o1[1] * o1[1]) + (o1[2] * o1[2] + o1[3] * o1[3]);
        }
        q += __shfl_xor(q, 16); q += __shfl_xor(q, 32);
        if (fq == 0) SS[(size_t)r * 32 + u.pn * 4 + wc] = q;
        asm volatile("" ::: "memory");
    }
}
__device__ __forceinline__ void epi_win(const MixBufs B, const LAS float* tbl, const f32x2* ROPE, const float* fbias, int pn_off, const f32x4 (&acc)[2][2][4][2], const Unit& u, int wr, int wc, int fr, int fq) {
    const int pn = u.pn + pn_off;
    int mode = 3, ld = 0, off1 = 0, ssld = 0; bf16_t* dst = nullptr; float* ssp = nullptr; float scm = 1.0f;
    if (pn < 2) { mode = 0; dst = mCQ(B) + pn * 256 + wc * 32; ld = 512; off1 = 128; ssp = mSSQ(B) + pn * 4 + wc; ssld = 8; }
    else if (pn == 2) { mode = 0; dst = mCKV(B) + wc * 32; ld = 256; off1 = 128; ssp = mSSKV(B) + wc; ssld = 4; }
    else if (pn < 5) { mode = 1; dst = mQS(B) + ((pn - 3) * 4 + wc) * 64; ld = 512; scm = QSCALE_64; }
    else if (pn == 5) { if (wc < 2) { mode = 1; dst = mKS(B) + wc * 64; ld = 128; } else { mode = 0; dst = mVS(B) + (wc - 2) * 32; ld = 128; off1 = 64; } }
    else if (pn == 12) { if (wc == 0) { mode = 1; dst = mKPE(B); ld = 64; } else if (wc == 1) mode = 2; }
    else { const int t = (pn - 6) >> 1, half = (pn - 6) & 1; mode = 0; dst = (t == 0 ? mQF(B) : (t == 1 ? mKF(B) : mVF(B))) + half * 256 + wc * 32; ld = 512; off1 = 128; if (t == 0) scm = QSCALE_64; }
    const int loff = fq * 8;
    Rope8 R[2];
    if (mode == 1) rope_load(R[0], ROPE, opaque(EPI_ROW(0)), fq * 8);
#pragma unroll
    for (int it = 0; it < 8; ++it) {
        const int ai = it >> 2, m = it & 3; const int r = opaque(EPI_ROW(it));
        if (mode == 1 && it + 1 < 8) rope_load(R[(it + 1) & 1], ROPE, opaque(EPI_ROW(it + 1)), fq * 8);
        const float rs = tbl[EPI_LROW(it)] * scm;
        const f32x4 (&a0)[2] = acc[ai][0][m]; const f32x4 (&a1)[2] = acc[ai][1][m];
        bf16_t* p = dst + (size_t)r * ld + loff;
        if (mode == 0) {
            *(u32x4*)p = pack8(a0[0], a0[1], rs); *(u32x4*)(p + off1) = pack8(a1[0], a1[1], rs);
            if (ssp) { float q = sq8(a0[0], a0[1], rs) + sq8(a1[0], a1[1], rs); q += __shfl_xor(q, 16); q += __shfl_xor(q, 32); if (fq == 0) ssp[(size_t)r * ssld] = q; }
        } else if (mode == 1) {
            u32x4 w1, w2; rope8(a0, a1, rs, R[it & 1], w1, w2); *(u32x4*)p = w1; *(u32x4*)(p + 32) = w2;
        } else if (mode == 2 && fq == 0) {
            float lf[8];
#pragma unroll
            for (int n = 0; n < 2; ++n)
#pragma unroll
                for (int i = 0; i < 4; ++i) { const float x = a0[n][i] * rs + fbias[4 * n + i]; lf[4 * n + i] = fminf(x, 0.f) - log1pf(expf(-fabsf(x))); }
            *(f32x4*)(mLOGF(B) + (size_t)r * 8) = (f32x4){lf[0], lf[1], lf[2], lf[3]}; *(f32x4*)(mLOGF(B) + (size_t)r * 8 + 4) = (f32x4){lf[4], lf[5], lf[6], lf[7]};
        }
        asm volatile("" ::: "memory");
    }
}
__device__ __forceinline__ void epi_qb(const MixBufs B, const f32x2* ROPE, const f32x4 (&acc)[2][2][4][2], const Unit& u, int wr, int wc, int fr, int fq) {
    const int pn = u.pn;
    const bool roped = pn >= 4;
    bf16_t* dst = roped ? mQM(B) + ((pn - 4) * 4 + wc) * 192 + 128 : mQM(B) + (2 * pn) * 192 + wc * 32;
    const int loff = fq * 8;
    Rope8 R[2]; f32x4 sq[2][2];
    { const int r0 = opaque(EPI_ROW(0)); if (roped) rope_load(R[0], ROPE, r0, fq * 8); const f32x4* p = (const f32x4*)(mSSQ(B) + (size_t)r0 * 8); sq[0][0] = p[0]; sq[0][1] = p[1]; }
#pragma unroll
    for (int it = 0; it < 8; ++it) {
        const int ai = it >> 2, m = it & 3; const int r = opaque(EPI_ROW(it));
        if (it + 1 < 8) { const int rn = opaque(EPI_ROW(it + 1)); if (roped) rope_load(R[(it + 1) & 1], ROPE, rn, fq * 8);
            const f32x4* p = (const f32x4*)(mSSQ(B) + (size_t)rn * 8); sq[(it + 1) & 1][0] = p[0]; sq[(it + 1) & 1][1] = p[1]; }
        const f32x4 sv = sq[it & 1][0] + sq[it & 1][1];
        const float rs = rsqrtf(((sv[0] + sv[1]) + (sv[2] + sv[3])) * (1.0f / 512) + RMS_EPS) * QSCALE_M;
        const f32x4 (&a0)[2] = acc[ai][0][m]; const f32x4 (&a1)[2] = acc[ai][1][m];
        bf16_t* p = dst + (size_t)r * 1536 + loff;
        if (!roped) { *(u32x4*)p = pack8(a0[0], a0[1], rs); *(u32x4*)(p + 192) = pack8(a1[0], a1[1], rs); }
        else { u32x4 w1, w2; rope8(a0, a1, rs, R[it & 1], w1, w2); *(u32x4*)p = w1; *(u32x4*)(p + 32) = w2; }
        asm volatile("" ::: "memory");
    }
}
__device__ __forceinline__ void epi_kvb(const MixBufs B, const f32x4 (&acc)[2][2][4][2], const Unit& u, int wr, int wc, int fr, int fq) {
    const int pn = u.pn, c8 = wc * 32 + fq * 8;
    bf16_t* dst = pn < 4 ? mKM(B) : mVM(B); const int hp = pn & 3;
    f32x4 sq[2];
    sq[0] = *(const f32x4*)(mSSKV(B) + (size_t)opaque(EPI_ROW(0)) * 4);
#pragma unroll
    for (int it = 0; it < 8; ++it) {
        const int ai = it >> 2, m = it & 3; const int r = opaque(EPI_ROW(it));
        if (it + 1 < 8) sq[(it + 1) & 1] = *(const f32x4*)(mSSKV(B) + (size_t)opaque(EPI_ROW(it + 1)) * 4);
        const f32x4 sv = sq[it & 1];
        const float rs = rsqrtf(((sv[0] + sv[1]) + (sv[2] + sv[3])) * (1.0f / 256) + RMS_EPS);
        *(u32x4*)(dst + (size_t)r * 1024 + (2 * hp) * 128 + c8) = pack8(acc[ai][0][m][0], acc[ai][0][m][1], rs);
        *(u32x4*)(dst + (size_t)r * 1024 + (2 * hp + 1) * 128 + c8) = pack8(acc[ai][1][m][0], acc[ai][1][m][1], rs);
        asm volatile("" ::: "memory");
    }
}
enum { EPI_SWIGLU = 0, EPI_RESID = 1, EPI_WIN = 2, EPI_QB = 3, EPI_KVB = 4 };
struct EpiAny {
    static constexpr bool PERM = true, AFTER_DRAIN = false;
    int kind; unsigned char* ws_; const float* base; float* out; float alpha; const float* fbias; LAS float* tbl; int pn_off;
    __device__ __forceinline__ void prefetch(const Unit& u, int idx, int tid) const {
        if (kind == EPI_SWIGLU || kind == EPI_WIN) {
#pragma unroll
            for (int pass = 0; pass < 2; ++pass) {
                const int row = pass * 128 + (tid >> 2), qtr = tid & 3;
                const f32x4* p = (const f32x4*)((const float*)(ws_ + WS_SS) + (size_t)(u.pm * 256 + row) * 32 + qtr * 8);
                const f32x4 sv = p[0] + p[1];
                float s = (sv[0] + sv[1]) + (sv[2] + sv[3]); s += __shfl_xor(s, 1); s += __shfl_xor(s, 2);
                if (qtr == 0) tbl[(idx & 1) * 256 + row] = rsqrtf(s * (1.0f / DM) + RMS_EPS);
                asm volatile("" ::: "memory");
            }
        }
    }
    __device__ __forceinline__ void operator()(const f32x4 (&acc)[2][2][4][2], const Unit& u, int wr, int wc, int fr, int fq, int ui) const {
        const LAS float* t = tbl + (ui & 1) * 256;
#define EPI_WS() unsigned char* ws = ws_; asm volatile("" : "+s"(ws))
        switch (kind) {
        case EPI_SWIGLU: { EPI_WS(); epi_swiglu((bf16_t*)(ws + WS_U + U_HID), t, acc, u, wr, wc, fr, fq); } break;
        case EPI_RESID: { EPI_WS(); epi_resid((bf16_t*)(ws + WS_XB), (float*)(ws + WS_SS), alpha, acc, u, wr, wc, fr, fq); } break;
        case EPI_WIN: { EPI_WS(); epi_win(MixBufs{ws + WS_U}, t, (const f32x2*)(ws + WS_ROPE), fbias, pn_off, acc, u, wr, wc, fr, fq); } break;
        case EPI_QB: { EPI_WS(); epi_qb(MixBufs{ws + WS_U}, (const f32x2*)(ws + WS_ROPE), acc, u, wr, wc, fr, fq); } break;
        default: { EPI_WS(); epi_kvb(MixBufs{ws + WS_U}, acc, u, wr, wc, fr, fq); } break;
        }
    }
};

enum { MAP_ID = 0, MAP_GU = 1, MAP_WIN = 2, MAP_QB = 3, MAP_KVB = 4 };
__device__ __forceinline__ int colmap(int kind, int r, int& which) {
    which = 0;
    const int tile = r >> 8, bj = (r >> 7) & 1, j = r & 127, wc = j >> 5, dd = j & 31;
    switch (kind) {
    case MAP_ID: return r;
    case MAP_GU: which = bj; return tile * 128 + j;
    case MAP_WIN:
        if (tile < 2) return r;
        if (tile == 2) return 512 + (r - 512);
        if (tile < 5) return 832 + ((tile - 3) * 4 + wc) * 64 + bj * 32 + dd;
        if (tile == 5) return wc < 2 ? 1344 + wc * 64 + bj * 32 + dd : 1472 + bj * 64 + (wc - 2) * 32 + dd;
        if (tile == 12) { if (bj == 0) return j < 32 ? 768 + j : (j < 40 ? 3136 + (j - 32) : -1); return j < 32 ? 768 + 32 + j : -1; }
        if (tile < 8) return 1600 + (r - 6 * 256);
        if (tile < 10) return 2112 + (r - 8 * 256);
        return 2624 + (r - 10 * 256);
    case MAP_QB:
        if (tile < 4) return (2 * tile + bj) * 192 + j;
        return ((tile - 4) * 4 + wc) * 192 + 128 + bj * 32 + dd;
    default:
        if (tile < 4) return (2 * tile + bj) * 256 + j;
        return (2 * (tile - 4) + bj) * 256 + 128 + j;
    }
}
struct TrJob { const float* W0; const float* W1; const float* gain; bf16_t* WT; int K, Nsrc, Ndst, kind; };
__device__ __forceinline__ void tr_item(const TrJob& J, LAS float* scr, int item, int lane) {
    const int nblk = J.Ndst / 64, kb = item / nblk, nb = item % nblk, k0 = 64 * kb, n0 = 64 * nb;
    const int n4 = (lane & 15) * 4, krow = lane >> 4;
    int which; const int sc = colmap(J.kind, n0 + n4, which);
    const float* W = J.W0 + (J.W1 ? (long long)which * (J.W1 - J.W0) : 0ll);
    f32x4 v[16];
#pragma unroll
    for (int i = 0; i < 16; ++i) v[i] = sc >= 0 ? *(const f32x4*)(W + (size_t)(k0 + 4 * i + krow) * J.Nsrc + sc) : (f32x4){0.f, 0.f, 0.f, 0.f};
    if (J.gain) {
#pragma unroll
        for (int i = 0; i < 16; ++i) v[i] *= J.gain[k0 + 4 * i + krow];
    }
#pragma unroll
    for (int i = 0; i < 16; ++i) { LAS float* d = scr + (4 * i + krow) * 65 + n4; d[0] = v[i][0]; d[1] = v[i][1]; d[2] = v[i][2]; d[3] = v[i][3]; }
    asm volatile("s_waitcnt lgkmcnt(0)" ::: "memory");
    const int c = lane & 7;
#pragma unroll
    for (int j = 0; j < 8; ++j) { const int n = (lane >> 3) + 8 * j; const LAS float* p = scr + (8 * c) * 65 + n;
        u32x4 o; o[0] = pk2(p[0 * 65], p[1 * 65]); o[1] = pk2(p[2 * 65], p[3 * 65]); o[2] = pk2(p[4 * 65], p[5 * 65]); o[3] = pk2(p[6 * 65], p[7 * 65]);
        *(u32x4*)(J.WT + ((size_t)((n0 + n) >> 8) * (J.K / 64) + kb) * 16384 + ((n0 + n) & 255) * 64 + 8 * c) = o; }
    asm volatile("s_waitcnt lgkmcnt(0)" ::: "memory");
}
__device__ const unsigned long long ROPE_F[32] = {2935890503282001226ull, 2201607287645322120ull, 1650972556229361476ull, 1238054759683200494ull, 928410095122917244ull, 696209354218470131ull, 522083363211519329ull, 391507290861131643ull, 293589050328200123ull, 220160728764532212ull, 165097255622936148ull, 123805475968320049ull, 92841009512291724ull, 69620935421847013ull, 52208336321151933ull, 39150729086113164ull, 29358905032820012ull, 22016072876453221ull, 16509725562293615ull, 12380547596832005ull, 9284100951229172ull, 6962093542184701ull, 5220833632115193ull, 3915072908611316ull, 2935890503282001ull, 2201607287645322ull, 1650972556229361ull, 1238054759683200ull, 928410095122917ull, 696209354218470ull, 522083363211519ull, 391507290861132ull};
constexpr int CTL_BAR_WORD = 1024;
#define XB_TMO      128
#define XB_XCNT(j)  (256  + 64 * (j))
#define XB_XSUB(j)  (1280 + 64 * (j))
#define XB_XGEN(j)  (2304 + 64 * (j))
#define XB_TOP      3328
#define XB_TOPGEN   3392
#define XCD_BAR_WORDS 3456
#define XB_SPIN_CAP (1u << 18)

__device__ __forceinline__ unsigned xb_ld(unsigned* p)              { return __hip_atomic_load(p, __ATOMIC_RELAXED, __HIP_MEMORY_SCOPE_AGENT); }
__device__ __forceinline__ unsigned xb_add(unsigned* p, unsigned v) { return __hip_atomic_fetch_add(p, v, __ATOMIC_RELAXED, __HIP_MEMORY_SCOPE_AGENT); }
__device__ __forceinline__ unsigned xb_xcc_id() { return (unsigned)__builtin_amdgcn_s_getreg((3 << 11) | 20) & 0xFu; }
#define XB_SPIN(cond, bar) do { unsigned _sp = 0; while (cond) { __builtin_amdgcn_s_sleep(1); \
    if ((++_sp & 255u) == 0u) { if (xb_ld(&(bar)[XB_TMO])) break; if (_sp > XB_SPIN_CAP) { atomicAdd(&(bar)[XB_TMO], 1u); break; } } } } while (0)

struct XcdBarrier {
    unsigned* bar; unsigned x;
    volatile LAS unsigned* st;
};

__device__ __forceinline__ XcdBarrier xcd_barrier_post(unsigned* bar, volatile LAS unsigned* st) {
    XcdBarrier b; b.bar = bar; b.x = xb_xcc_id(); b.st = st;
    if (threadIdx.x == 0) (void)xb_add(&bar[XB_XCNT(b.x)], 1u);
    return b;
}
__device__ __forceinline__ void xcd_barrier_complete(unsigned* bar, unsigned x, unsigned& nloc, unsigned& nx) {
    const unsigned G = gridDim.x * gridDim.y * gridDim.z;
    unsigned sum, cnt, mine, sp = 0u;
    for (;;) {
        sum = 0u; cnt = 0u; mine = 0u;
#pragma unroll
        for (unsigned j = 0; j < 16; ++j) { const unsigned c = xb_ld(&bar[XB_XCNT(j)]); sum += c; cnt += (c > 0u) ? 1u : 0u; mine = (j == x) ? c : mine; }
        if (sum == G) break;
        __builtin_amdgcn_s_sleep(1);
        if ((++sp & 255u) == 0u) { if (xb_ld(&bar[XB_TMO])) break; if (sp > XB_SPIN_CAP) { atomicAdd(&bar[XB_TMO], 1u); break; } }
    }
    nloc = mine > 0u ? mine : 1u; nx = cnt > 0u ? cnt : 1u;
}

__device__ __forceinline__ void xcd_barrier(const XcdBarrier& b) {
    asm volatile("s_waitcnt vmcnt(0)" ::: "memory");
    __syncthreads();
    if (threadIdx.x == 0) {
        unsigned* bar = b.bar;
        __builtin_amdgcn_s_waitcnt(0);
        unsigned nloc = b.st[0], nx = b.st[1];
        if (nloc == 0u) { xcd_barrier_complete(bar, b.x, nloc, nx); b.st[0] = nloc; b.st[1] = nx; }
        const unsigned old = xb_add(&bar[XB_XSUB(b.x)], 1u);
        const unsigned gen = old / nloc;
        if (old + 1u == (gen + 1u) * nloc) {
            __builtin_amdgcn_fence(__ATOMIC_RELEASE, "agent");
            asm volatile("s_waitcnt vmcnt(0)" ::: "memory");
            const unsigned og = xb_add(&bar[XB_TOP], 1u);
            const unsigned tg = og / nx;
            if (og + 1u == (tg + 1u) * nx) xb_add(&bar[XB_TOPGEN], 1u);
            else XB_SPIN(xb_ld(&bar[XB_TOPGEN]) == tg, bar);
            __builtin_amdgcn_fence(__ATOMIC_ACQUIRE, "agent");
            xb_add(&bar[XB_XGEN(b.x)], 1u);
            asm volatile("s_waitcnt vmcnt(0)" ::: "memory");
        } else {
            XB_SPIN(xb_ld(&bar[XB_XGEN(b.x)]) == gen, bar);
            __builtin_amdgcn_fence(__ATOMIC_ACQUIRE, "agent");
            asm volatile("s_waitcnt vmcnt(0)" ::: "memory");
        }
    }
    __syncthreads();
}

constexpr int CTL_LOC_SUB = 4608, CTL_LOC_GEN = 5632;
constexpr int CTL_WORDS = 6720;
static_assert(CTL_BAR_WORD + XCD_BAR_WORDS <= CTL_LOC_SUB && CTL_LOC_GEN + 64 * 16 <= CTL_WORDS && CTL_WORDS * 4 <= (int)WS_W, "control words");
__device__ __forceinline__ void xcc_local_barrier(unsigned* ctl, unsigned x, volatile LAS unsigned* st) {
    asm volatile("s_waitcnt vmcnt(0)" ::: "memory");
    __syncthreads();
    if (threadIdx.x == 0) {
        __builtin_amdgcn_s_waitcnt(0);
        const unsigned nloc = st[0];
        unsigned* sub = ctl + CTL_LOC_SUB + 64 * x; unsigned* gen = ctl + CTL_LOC_GEN + 64 * x;
        const unsigned old = xb_add(sub, 1u), g = old / nloc;
        if (old + 1u == (g + 1u) * nloc) xb_add(gen, 1u);
        else XB_SPIN(xb_ld(gen) == g, ctl + CTL_BAR_WORD);
        __builtin_amdgcn_fence(__ATOMIC_ACQUIRE, "agent");
        asm volatile("s_waitcnt vmcnt(0)" ::: "memory");
    }
    __syncthreads();
}
struct Args { const float* in[20]; float* out; unsigned char* ws; int ph_lo, ph_hi; };

typedef const Args __attribute__((address_space(4)))* KArgsP;
#ifndef DEFER_L1
#define DEFER_L1 1
#endif
__device__ __forceinline__ TrJob make_job(KArgsP a, unsigned char* ws, int l, int j) {
    unsigned char* wl = ws + WS_W + (size_t)l * LAYER_W;
    const int i0 = j == 0 ? 3 : j == 1 ? 5 : j == 2 ? 7 : j == 3 ? 9 : j == 4 ? 11 : j == 5 ? 14 : j == 6 ? 16 : 18;
    const int ig = j == 0 ? 2 : j == 2 ? 6 : j == 3 ? 8 : j == 4 ? 10 : j == 6 ? 15 : -1;
    const int K = (j == 1 || j == 7) ? DFF : j == 3 ? 512 : j == 4 ? 256 : DM;
    const int Nsrc = (j == 0 || j == 6) ? DFF : j == 2 ? NIN_SRC : j == 3 ? 1536 : DM;
    const int Ndst = (j == 0 || j == 6) ? NGU : j == 2 ? NIN : j == 3 ? 1536 : DM;
    const int kind = (j == 0 || j == 6) ? MAP_GU : j == 2 ? MAP_WIN : j == 3 ? MAP_QB : j == 4 ? MAP_KVB : MAP_ID;
    const size_t lwo = j == 0 ? LW_GU1 : j == 1 ? LW_D1 : j == 2 ? LW_IN : j == 3 ? LW_QB : j == 4 ? LW_KV : j == 5 ? LW_OUT : j == 6 ? LW_GU2 : LW_D2;
    TrJob J;
    J.W0 = a->in[i0] + (size_t)l * K * Nsrc; J.W1 = (j == 0 || j == 6) ? a->in[i0 + 1] + (size_t)l * K * Nsrc : nullptr;
    J.gain = ig >= 0 ? a->in[ig >= 0 ? ig : 0] + l * K : nullptr; J.WT = (bf16_t*)(wl + lwo); J.K = K; J.Nsrc = Nsrc; J.Ndst = Ndst; J.kind = kind;
    return J;
}
constexpr int TRN[8] = {(NGU / 64) * (DM / 64), (DM / 64) * (DFF / 64), (NIN / 64) * (DM / 64), (1536 / 64) * (512 / 64), (2048 / 64) * (256 / 64), (DM / 64) * (DM / 64), (NGU / 64) * (DM / 64), (DM / 64) * (DFF / 64)};
constexpr int NTR = TRN[0] + TRN[1] + TRN[2] + TRN[3] + TRN[4] + TRN[5] + TRN[6] + TRN[7];
constexpr int CV_PER_WAVE = 9, CV_PER_ITEM = 8 * CV_PER_WAVE, NCV = (NTR + CV_PER_ITEM - 1) / CV_PER_ITEM;
__device__ __forceinline__ void conv_item(KArgsP a, unsigned char* ws, int c, LAS unsigned char* lds) {
    int tid_l = threadIdx.x; asm volatile("" : "+v"(tid_l)); const int tid = tid_l, lane = tid & 63, wave = __builtin_amdgcn_readfirstlane(tid >> 6);
    LAS float* scr = (LAS float*)(lds + wave * 16640);
#pragma nounroll
    for (int k = 0; k < CV_PER_WAVE; ++k) {
        int t = c * CV_PER_ITEM + wave * CV_PER_WAVE + k;
        if (t >= NTR) break;
        int j = 0;
#pragma unroll
        for (int q = 0; q < 7; ++q) if (j == q && t >= TRN[q]) { t -= TRN[q]; j = q + 1; }
        const TrJob J = make_job(a, ws, 1, j);
        tr_item(J, scr, t, lane);
    }
}
__device__ __forceinline__ void prep_phase(KArgsP a, LAS unsigned char* lds) {
    int tid_l = threadIdx.x; asm volatile("" : "+v"(tid_l)); const int tid = tid_l, lane = tid & 63, wave = tid >> 6;
    const int gw = blockIdx.x * 8 + wave, NGW = gridDim.x * 8;
    unsigned char* ws = a->ws;
    if (blockIdx.x == 0) for (int i = tid; i < CTL_WORDS; i += 512) ((unsigned*)(ws + WS_CTL))[i] = 0u;
    LAS float* scr = (LAS float*)(lds + wave * 16640);
#pragma nounroll
    for (int l = 0; l < (DEFER_L1 ? 1 : DEPTH); ++l) {
#pragma nounroll
        for (int j = 0; j < 8; ++j) {
            const TrJob J = make_job(a, ws, l, j);
            const int nitems = (J.Ndst / 64) * (J.K / 64);
            for (int it = gw; it < nitems; it += NGW) tr_item(J, scr, it, lane);
        }
    }
    const float* x = a->in[0]; bf16_t* XB = (bf16_t*)(ws + WS_XB); float* SS = (float*)(ws + WS_SS);
    for (int m = gw; m < M; m += NGW) {
        const f32x4* xr = (const f32x4*)(x + (size_t)m * DM) + lane; float s = 0.f;
        unsigned long long* o8 = (unsigned long long*)(XB + (size_t)m * DM) + lane;
#pragma unroll
        for (int j = 0; j < 8; ++j) { const f32x4 v = xr[64 * j]; s += (v[0] * v[0] + v[1] * v[1]) + (v[2] * v[2] + v[3] * v[3]);
            o8[64 * j] = (unsigned long long)pk2(v[0], v[1]) | ((unsigned long long)pk2(v[2], v[3]) << 32); }
        s = wave_sum(s);
        if (lane < 32) SS[(size_t)m * 32 + lane] = lane == 0 ? s : 0.f;
    }
    const int* pos = (const int*)a->in[1]; f32x2* ROPE = (f32x2*)(ws + WS_ROPE);
    for (int e = blockIdx.x * 512 + tid; e < M * 32; e += gridDim.x * 512) {
        const int m = e >> 5, i = e & 31;
        const unsigned long long u = (unsigned long long)(long long)pos[m] * ROPE_F[i];
        const float y = (float)(int)(u >> 32) * (0.25f * 6.283185307179586f / 4294967296.0f), y2 = y * y;
        float sn = y * (1.0f + y2 * (-1.0f / 6 + y2 * (1.0f / 120 + y2 * (-1.0f / 5040 + y2 * (1.0f / 362880)))));
        float cs = 1.0f + y2 * (-0.5f + y2 * (1.0f / 24 + y2 * (-1.0f / 720 + y2 * (1.0f / 40320 + y2 * (-1.0f / 3628800)))));
        const float s2 = 2.0f * sn * cs, c2 = 1.0f - 2.0f * sn * sn; sn = 2.0f * s2 * c2; cs = 1.0f - 2.0f * s2 * s2;
        ROPE[e] = (f32x2){(float)cs, (float)sn};
    }
}

__device__ __forceinline__ void scan_phase(const MixBufs& B, LAS unsigned char* lds) {
    int tid_l = threadIdx.x; asm volatile("" : "+v"(tid_l)); const int tid = tid_l, lane = tid & 63, wave = tid >> 6;
    LAS float* wt = (LAS float*)(lds + LDS_X);
    for (int item = blockIdx.x; item < 256; item += gridDim.x) {
        const int seq = item >> 4, chunk = item & 15, b = seq >> 3, h = seq & 7;
        const size_t tok = (size_t)b * SEQ + chunk * 512 + tid;
        float v = mLOGF(B)[tok * 8 + h];
#pragma unroll
        for (int o = 1; o < 64; o <<= 1) { const float t = __shfl_up(v, o); if (lane >= o) v += t; }
        if (lane == 63) wt[wave] = v;
        __syncthreads();
        float pre = 0.f;
        for (int w = 0; w < wave; ++w) pre += wt[w];
        v += pre;
        mCUM(B)[tok * 8 + h] = v;
        if (tid == 511) mCHS(B)[seq * 16 + chunk] = v;
        float k2 = 0.f;
        { const u32x4* kr = (const u32x4*)(mKF(B) + tok * 512 + h * 64);
#pragma unroll
          for (int j = 0; j < 8; ++j) { const u32x4 w = kr[j];
#pragma unroll
              for (int e = 0; e < 4; ++e) { const float lo = __uint_as_float(w[e] << 16), hi2 = __uint_as_float(w[e] & 0xffff0000u); k2 += lo * lo + hi2 * hi2; } } }
#pragma unroll
        for (int o = 1; o < 64; o <<= 1) k2 = fmaxf(k2, __shfl_xor(k2, o));
        __syncthreads();
        if (lane == 0) wt[wave] = k2;
        __syncthreads();
        if (tid == 0) { float mxk = wt[0]; for (int w = 1; w < 8; ++w) mxk = fmaxf(mxk, wt[w]); mKNM(B)[seq * 16 + chunk] = mxk; }
        __syncthreads();
    }
}

#define MFMA32(a, b, c) __builtin_amdgcn_mfma_f32_32x32x16_bf16((a), (b), (c), 0, 0, 0)
__device__ __forceinline__ bf16x8 packp(const f32x16& p, int s) {
    u32x4 w; w[0] = pk2(p[8 * s], p[8 * s + 1]); w[1] = pk2(p[8 * s + 2], p[8 * s + 3]); w[2] = pk2(p[8 * s + 4], p[8 * s + 5]); w[3] = pk2(p[8 * s + 6], p[8 * s + 7]);
    return __builtin_bit_cast(bf16x8, w);
}
template <int DQ, int DK1, int DV, int MODE>
__device__ __forceinline__ void attn_item(const bf16_t* Qp, int ldq, const bf16_t* K1, int ldk1, const bf16_t* K2, const bf16_t* Vp, int ldv, bf16_t* Op,
                                          const float* CUM, const float* CHS, int h, float sink2, int b, int qb, LAS unsigned char* lds) {
    constexpr int KS = DQ * 2 + 16, VS = DV * 2 + 64, KBYTES = 64 * KS, VBYTES = 64 * VS;
    constexpr int OFF_K = 0, OFF_V = 2 * KBYTES, OFF_CK = OFF_V + 2 * VBYTES, OFF_PRE = OFF_CK + 512;
    static_assert(KS % 16 == 0 && VS % 16 == 0 && OFF_PRE + 256 <= LDS_X, "attention staging geometry");
    int tid_l = threadIdx.x; asm volatile("" : "+v"(tid_l));
    const int tid = tid_l, lane = tid & 63, wave = __builtin_amdgcn_readfirstlane(tid >> 6), r32 = lane & 31, hi = lane >> 5;
    const size_t tok0 = (size_t)b * SEQ;
    const int q0 = qb * 256, q0w = q0 + wave * 32, qpos = q0w + r32;
    LAS float* PRE = (LAS float*)(lds + OFF_PRE);
    int kt0 = 0; const int kt1 = 4 * (qb + 1);
    if (MODE == 2) { kt0 = 4 * qb - 2; if (kt0 < 0) kt0 = 0; }
    float cq2 = 0.f, crefloc = 0.f;
    if (MODE == 1) {
        const int cq = qb >> 1;
        if (tid == 0) { float acc = 0.f; PRE[cq] = 0.f; for (int c = cq - 1; c >= 0; --c) { acc -= CHS[(b * 8 + h) * 16 + c]; PRE[c] = acc; } }
        crefloc = CUM[(tok0 + q0) * 8 + h];
        cq2 = (CUM[(tok0 + qpos) * 8 + h] - crefloc) * LOG2E;
        __syncthreads();
    }
    bf16x8 qf[DQ / 16];
    { const bf16_t* qrow = Qp + (tok0 + qpos) * (size_t)ldq + hi * 8;
#pragma unroll
      for (int ks = 0; ks < DQ / 16; ++ks) qf[ks] = *(const bf16x8*)(qrow + ks * 16); }
    if (MODE == 1) {
        LAS float* WQ = (LAS float*)(lds + OFF_PRE + 64); LAS int* KT0 = (LAS int*)(lds + OFF_PRE + 128);
        float q2 = 0.f;
#pragma unroll
        for (int ks = 0; ks < DQ / 16; ++ks)
#pragma unroll
            for (int e = 0; e < 8; ++e) { const float x = __uint_as_float((unsigned)(unsigned short)qf[ks][e] << 16); q2 += x * x; }
        { auto rr = __builtin_amdgcn_permlane32_swap(__float_as_uint(q2), __float_as_uint(q2), false, false); q2 = __uint_as_float(rr[0]) + __uint_as_float(rr[1]); }
#pragma unroll
        for (int o = 1; o < 32; o <<= 1) q2 = fmaxf(q2, __shfl_xor(q2, o));
        if (lane == 0) WQ[wave] = q2;
        if (tid == 0) KT0[0] = 0;
        __syncthreads();
        float qm = WQ[0], km = CHS[256 + (b * 8 + h) * 16];
#pragma unroll
        for (int w = 1; w < 8; ++w) qm = fmaxf(qm, WQ[w]);
        for (int c = 1; c < 16; ++c) km = fmaxf(km, CHS[256 + (b * 8 + h) * 16 + c]);
        const float T = (150.0f + 1.0f + 2.02f * sqrtf(qm) * sqrtf(km)) * (1.0f / LOG2E);
        if (tid < 128) {
            bool skip = false;
            if (tid < 4 * qb) { const size_t sl = tok0 + (size_t)tid * 64 + 63; skip = ((CUM[sl * 8 + h] - crefloc) + PRE[tid >> 3]) >= T; }
            const unsigned long long bal = __builtin_amdgcn_ballot_w64(skip);
            const int lead = bal == ~0ull ? 64 : __builtin_ctzll(~bal);
            if (lane == 0) { if (wave == 0) { if (lead < 64) KT0[0] = lead; else KT0[0] = 64; } }
            __builtin_amdgcn_s_waitcnt(0);
            if (wave == 1 && lane == 0) WQ[8] = (float)lead;
        }
        __syncthreads();
        { int k0s = KT0[0]; if (k0s == 64) k0s = 64 + (int)WQ[8]; kt0 = k0s; }
        __syncthreads();
    }
    float ckreg = 0.f;
    constexpr int KCH = KS / 16, KDAT = DQ / 8, VCH = VS / 16, VDAT = DV / 8;
    auto dma_k = [&](int kt, int buf) {
        const bf16_t* k1t = K1 + (tok0 + (size_t)kt * 64) * (size_t)ldk1; const bf16_t* k2t = K2 + (tok0 + (size_t)kt * 64) * (size_t)(DQ - DK1);
#pragma unroll
        for (int j = 0; j < (KCH + 7) / 8; ++j) { const int i = j * 8 + wave;
            if (i < KCH) { const int c = i * 64 + lane, row = c / KCH; int ch = c - row * KCH; if (ch >= KDAT) ch = KDAT - 1;
                const bf16_t* src = (DK1 == DQ || ch * 8 < DK1) ? k1t + (unsigned)(row * ldk1 + ch * 8) : k2t + (unsigned)(row * (DQ - DK1) + (ch * 8 - DK1));
                __builtin_amdgcn_global_load_lds((const unsigned*)src, (LAS unsigned*)(lds + OFF_K + buf * KBYTES + i * 1024), 16, 0, 0); } }
    };
    auto dma_v = [&](int kt, int buf) {
        const bf16_t* vt = Vp + (tok0 + (size_t)kt * 64) * (size_t)ldv;
#pragma unroll
        for (int j = 0; j < (VCH + 7) / 8; ++j) { const int i = j * 8 + wave;
            if (i < VCH) { const int c = i * 64 + lane, row = c / VCH; int ch = c - row * VCH; if (ch >= VDAT) ch = VDAT - 1;
                __builtin_amdgcn_global_load_lds((const unsigned*)(vt + (unsigned)(row * ldv + ch * 8)), (LAS unsigned*)(lds + OFF_V + buf * VBYTES + i * 1024), 16, 0, 0); } }
        if (MODE == 1 && tid < 64) ckreg = ((CUM[(tok0 + (size_t)kt * 64 + tid) * 8 + h] - crefloc) + PRE[kt >> 3]) * LOG2E;
    };
    auto store_ck = [&](int buf) { if (MODE == 1 && tid < 64) *(LAS float*)(lds + OFF_CK + buf * 256 + tid * 4) = ckreg; };
    auto qk = [&](int buf, f32x16& a0, f32x16& a1) {
#pragma unroll
        for (int i = 0; i < 16; ++i) { a0[i] = 0.f; a1[i] = 0.f; }
        const LAS unsigned char* kb = lds + OFF_K + buf * KBYTES + r32 * KS + hi * 16;
#pragma unroll
        for (int ks = 0; ks < DQ / 16; ++ks) {
            const bf16x8 k0 = *(const LAS bf16x8*)(kb + ks * 32), k1 = *(const LAS bf16x8*)(kb + 32 * KS + ks * 32);
            a0 = MFMA32(k0, qf[ks], a0); a1 = MFMA32(k1, qf[ks], a1);
        }
    };
    f32x16 o[DV / 32];
#pragma unroll
    for (int d = 0; d < DV / 32; ++d)
#pragma unroll
        for (int i = 0; i < 16; ++i) o[d][i] = 0.f;
    float m_run = -1e30f, l_run = 0.f;
    dma_k(kt0, 0); dma_v(kt0, 0); store_ck(0);
    if (kt0 + 1 < kt1) dma_k(kt0 + 1, 1);
    asm volatile("s_waitcnt vmcnt(0)" ::: "memory");
    __syncthreads();
    f32x16 p0, p1, n0, n1;
    qk(0, p0, p1);
    for (int kt = kt0; kt < kt1; ++kt) {
        const int cur = (kt - kt0) & 1; const bool more1 = kt + 1 < kt1, more2 = kt + 2 < kt1;
        if (more2) dma_k(kt + 2, cur);
        if (more1) dma_v(kt + 1, cur ^ 1);
        {
            if (MODE == 1) {
                const LAS float* ck = (const LAS float*)(lds + OFF_CK + cur * 256);
#pragma unroll
                for (int g = 0; g < 4; ++g) { const f32x4 c0 = *(const LAS f32x4*)(ck + 8 * g + 4 * hi), c1 = *(const LAS f32x4*)(ck + 32 + 8 * g + 4 * hi);
#pragma unroll
                    for (int i = 0; i < 4; ++i) { p0[4 * g + i] += cq2 - c0[i]; p1[4 * g + i] += cq2 - c1[i]; } }
            }
            const bool diag = (64 * kt + 63 > q0w) || (MODE == 2 && 64 * kt <= q0w + 31 - 128);
            if (diag) {
#pragma unroll
                for (int i = 0; i < 16; ++i) { const int key = 64 * kt + (i & 3) + 8 * (i >> 2) + 4 * hi;
                    bool ok0 = key <= qpos, ok1 = key + 32 <= qpos;
                    if (MODE == 2) { ok0 = ok0 && key > qpos - 128; ok1 = ok1 && key + 32 > qpos - 128; }
                    if (!ok0) p0[i] = -INFINITY; if (!ok1) p1[i] = -INFINITY; }
            }
        }
        float mn;
        {
            float ma = fmaxf(fmaxf(p0[0], p0[1]), p1[0]), mb = fmaxf(fmaxf(p0[2], p0[3]), p1[1]);
            ma = fmaxf(fmaxf(ma, p1[2]), p1[3]);
#pragma unroll
            for (int i = 4; i < 16; i += 4) { ma = fmaxf(fmaxf(ma, p0[i]), p0[i + 1]); mb = fmaxf(fmaxf(mb, p0[i + 2]), p0[i + 3]); ma = fmaxf(fmaxf(ma, p1[i]), p1[i + 1]); mb = fmaxf(fmaxf(mb, p1[i + 2]), p1[i + 3]); }
            float mx = fmaxf(ma, mb);
            { auto rr = __builtin_amdgcn_permlane32_swap(__float_as_uint(mx), __float_as_uint(mx), false, false); mx = fmaxf(__uint_as_float(rr[0]), __uint_as_float(rr[1])); }
            mn = fmaxf(m_run, mx);
            const float alpha = __builtin_amdgcn_exp2f(m_run - mn);
            const bool grew = mn > m_run; m_run = mn;
            l_run *= alpha;
            if (__builtin_amdgcn_ballot_w64(grew) != 0ull) {
#pragma unroll
                for (int d = 0; d < DV / 32; ++d) o[d] *= alpha;
            }
        }
        bf16x8 pf[4];
        {
            qk(cur ^ 1, n0, n1);
            float rs0 = 0.f, rs1 = 0.f;
#pragma unroll
            for (int i = 0; i < 16; ++i) { p0[i] = __builtin_amdgcn_exp2f(p0[i] - mn); p1[i] = __builtin_amdgcn_exp2f(p1[i] - mn); rs0 += p0[i]; rs1 += p1[i]; }
            l_run += rs0 + rs1;
            pf[0] = packp(p0, 0); pf[1] = packp(p0, 1); pf[2] = packp(p1, 0); pf[3] = packp(p1, 1);
#pragma unroll
            for (int i = 0; i < DQ / 8; ++i) {
                __builtin_amdgcn_sched_group_barrier(0x100, 1, 0);
                __builtin_amdgcn_sched_group_barrier(0x008, 1, 0);
                __builtin_amdgcn_sched_group_barrier(0x002, DQ == 192 ? 4 : 12, 0);
                __builtin_amdgcn_sched_group_barrier(0x400, DQ == 192 ? 3 : 8, 0);
            }
            asm volatile("" : "+v"(pf[0]), "+v"(pf[1]), "+v"(pf[2]), "+v"(pf[3]), "+v"(l_run));
        }
        {
            const LAS unsigned char* vb = lds + OFF_V + cur * VBYTES + (4 * hi + ((lane & 15) >> 2)) * VS + (16 * ((lane >> 4) & 1) + 4 * (lane & 3)) * 2;
#pragma unroll
            for (int d = 0; d < DV / 32; ++d)
#pragma unroll
                for (int kk = 0; kk < 4; ++kk) {
                    const v4i16_t lo = __builtin_amdgcn_ds_read_tr16_b64_v4i16((LAS v4i16_t*)(vb + (16 * kk) * VS + d * 64));
                    const v4i16_t hh = __builtin_amdgcn_ds_read_tr16_b64_v4i16((LAS v4i16_t*)(vb + (16 * kk + 8) * VS + d * 64));
                    const bf16x8 vf = {lo[0], lo[1], lo[2], lo[3], hh[0], hh[1], hh[2], hh[3]};
                    o[d] = MFMA32(vf, pf[kk], o[d]);
                    if (kk == 3) asm volatile("" ::: "memory");
                }
        }
        if (more1) store_ck(cur ^ 1);
        asm volatile("s_waitcnt vmcnt(0)" ::: "memory");
        __syncthreads();
        p0 = n0; p1 = n1;
    }
    float l; { auto rr = __builtin_amdgcn_permlane32_swap(__float_as_uint(l_run), __float_as_uint(l_run), false, false); l = __uint_as_float(rr[0]) + __uint_as_float(rr[1]); }
    if (MODE == 2) l += __builtin_amdgcn_exp2f(sink2 - m_run);
    const float inv = 1.0f / l;
    bf16_t* orow = Op + (tok0 + qpos) * (size_t)DM;
#pragma unroll
    for (int d = 0; d < DV / 32; ++d)
#pragma unroll
        for (int g = 0; g < 4; ++g) { u32x2 w; w[0] = pk2(o[d][4 * g] * inv, o[d][4 * g + 1] * inv); w[1] = pk2(o[d][4 * g + 2] * inv, o[d][4 * g + 3] * inv);
            *(u32x2*)(orow + 32 * d + 8 * g + 4 * hi) = w; }
}

__device__ __forceinline__ void final_phase(float* out, const bf16_t* XB, const float* SS, const float* g) {
    int tid_l = threadIdx.x; asm volatile("" : "+v"(tid_l)); const int tid = tid_l, lane = tid & 63, wave = tid >> 6;
    const int gw = blockIdx.x * 8 + wave, NGW = gridDim.x * 8;
    for (int m = gw; m < M; m += NGW) {
        const float rs = rsqrtf(sum_ss(SS + (size_t)m * 32, 8) * (1.0f / DM) + RMS_EPS);
        const u32x4* xr = (const u32x4*)(XB + (size_t)m * DM) + lane; f32x4* orow = (f32x4*)(out + (size_t)m * DM); const f32x4* gr = (const f32x4*)g;
#pragma unroll
        for (int j = 0; j < 4; ++j) { const u32x4 w = xr[64 * j]; const int c4 = (64 * j + lane) * 2;
            orow[c4] = bf_lo4(w) * rs * gr[c4]; orow[c4 + 1] = bf_hi4(w) * rs * gr[c4 + 1]; }
    }
}

#ifndef PH_MASK
#define PH_MASK 255
#endif
constexpr int N_STEPS = 22;
__device__ __forceinline__ void attn_phase(KArgsP ka, unsigned char* ws, const float* sinks, int l, int cidx, LAS unsigned char* lds) {
    LAS int* slot = (LAS int*)(lds + LDS_X + 1024);
    unsigned* counter = (unsigned*)(ws + WS_CTL) + cidx;
    const MixBufs B{ws + WS_U};
    int tid_l = threadIdx.x; asm volatile("" : "+v"(tid_l)); const int tid = tid_l;
    for (;;) {
        __syncthreads();
        if (tid == 0) *slot = (int)atomicAdd(counter, 1u);
        __syncthreads();
        int idx = *slot;
        if (DEFER_L1 && l == 0) {
            if (idx >= 6 * NCV + (1536 - 5 * NCV)) break;
            if (idx < 6 * NCV) { const int g = idx / 6, pos = idx - 6 * g; if (pos == 5) { conv_item(ka, ws, g, lds); continue; } idx = 5 * g + pos; }
            else idx = 5 * NCV + (idx - 6 * NCV);
        }
        if (idx >= 1536) break;
        const int kind = idx >> 9, r = idx & 511, qb = 31 - (r >> 4), bh = r & 15, b = bh >> 3, h = bh & 7;
#if PH_MASK & 64
        if (kind == 0)
            attn_item<192, 128, 128, 0>(mQM(B) + h * 192, 1536, mKM(B) + h * 128, 1024, mKPE(B), mVM(B) + h * 128, 1024, mMIX(B) + h * 128, nullptr, nullptr, h, 0.f, b, qb, lds);
        else
#endif
        if (kind == 1)
            attn_item<64, 64, 64, 1>(mQF(B) + h * 64, 512, mKF(B) + h * 64, 512, nullptr, mVF(B) + h * 64, 512, mMIX(B) + 1536 + h * 64, mCUM(B), mCHS(B), h, 0.f, b, qb, lds);
        else
            attn_item<64, 64, 64, 2>(mQS(B) + h * 64, 512, mKS(B) + (h >> 2) * 64, 128, nullptr, mVS(B) + (h >> 2) * 64, 128, mMIX(B) + 1024 + h * 64, nullptr, nullptr, h, sinks[h] * LOG2E, b, qb, lds);
    }
}
__device__ __forceinline__ bool probe_rep(int st) {
#if defined(PROBE_MASK) && PROBE_MASK
    if (st == 0) return (PROBE_MASK >> 10) & 1;
    if (st >= N_STEPS - 1) return false;
    const int l = (st - 1) / 10, s = (st - 1) - 10 * l;
    if (s == 1 && l != 0) return false;
    return (PROBE_MASK >> s) & 1;
#else
    return false;
#endif
}
__global__ void __launch_bounds__(512, 2) mega_fwd(Args a) {
    extern __shared__ __attribute__((aligned(16))) unsigned char lds_raw[];
    LAS unsigned char* lds = (LAS unsigned char*)lds_raw;
    cg::grid_group grid = cg::this_grid();
    typedef const Args __attribute__((address_space(4)))* KArgs;
    const int ph_lo = a.ph_lo, ph_hi = a.ph_hi;
    int rep = 0; bool xb_posted = false;
    if (threadIdx.x < 2) ((LAS unsigned*)(lds + LDS_X + 2048))[threadIdx.x] = 0u;
    __syncthreads();
#pragma nounroll
    for (int st = ph_lo; st < ph_hi; (PROBE_MASK != 0 && rep == 0 && probe_rep(st)) ? (rep = 1) : (rep = 0, ++st)) {
        const int l = (st - 1) / 10, s = (st - 1) - 10 * l;
        const bool is_layer = st > 0 && st < N_STEPS - 1;
        KArgs ka = (KArgs)__builtin_amdgcn_kernarg_segment_ptr(); asm volatile("" : "+s"(ka));
        unsigned char* ws = ka->ws;
        if (st > ph_lo && !(is_layer && s == 4)) {
            XcdBarrier xb_; xb_.bar = (unsigned*)(ws + WS_CTL) + CTL_BAR_WORD; xb_.x = xb_xcc_id(); xb_.st = (volatile LAS unsigned*)(lds + LDS_X + 2048);
            LAS unsigned* vc = (LAS unsigned*)(lds + LDS_X + 2064);
            if (!xb_posted) {
                grid.sync(); (void)xcd_barrier_post(xb_.bar, xb_.st); xb_posted = true;
                unsigned* ctl = (unsigned*)(ws + WS_CTL);
                if (threadIdx.x == 0) vc[1] = atomicAdd(ctl + 64 + xb_.x, 1u);
                xcd_barrier(xb_);
                if (threadIdx.x == 0) { bool ok = (gridDim.x % 8) == 0 && xb_.x < 8; for (int j = 0; j < 8; ++j) ok = ok && (__hip_atomic_load(ctl + 64 + j, __ATOMIC_RELAXED, __HIP_MEMORY_SCOPE_AGENT) == gridDim.x / 8);
                    vc[0] = ok ? vc[1] * 8u + xb_.x : blockIdx.x; vc[2] = ok ? 1u : 0u; }
                __syncthreads();
            }
            else {
                const bool local_seam = is_layer && (s == 1 || s == 8 || s == 9 || (s == 0 && l > 0)) && vc[2] != 0u;
                if (local_seam) xcc_local_barrier((unsigned*)(ws + WS_CTL), xb_.x, xb_.st);
                else xcd_barrier(xb_);
            }
        }
#if PH_MASK & 1
        if (st == 0) { prep_phase(ka, lds); continue; }
#endif
#if PH_MASK & 2
        if (st == N_STEPS - 1) { final_phase(ka->out, (const bf16_t*)(ws + WS_XB), (const float*)(ws + WS_SS), ka->in[19]); continue; }
#endif
        if (!is_layer) continue;
#if PH_MASK & 4
        if (s == 5) { scan_phase(MixBufs{ws + WS_U}, lds); continue; }
#endif
#if PH_MASK & 8
        if (s == 6) { attn_phase(ka, ws, ka->in[12] + l * 8, l, l + 2 * rep, lds); continue; }
#endif
#if PH_MASK & 16
        if (s == 5 || s == 6) continue;
        const int cb = (int)((LAS unsigned*)(lds + LDS_X + 2064))[0]; int sub_g = gridDim.x, sub_c = cb;
        const bool split_ok = gridDim.x >= 128;
        unsigned char* wl = ws + WS_W + (size_t)l * LAYER_W;
        pg8::Gemm g; EpiAny E; E.tbl = (LAS float*)(lds + LDS_X); E.ws_ = ws; E.base = nullptr; E.out = ka->out; E.alpha = 0.f; E.fbias = nullptr; E.pn_off = 0;
        const bf16_t* XB = (const bf16_t*)(ws + WS_XB); const bf16_t* HID = (const bf16_t*)(ws + WS_U + U_HID);
        switch (s) {
        case 0: g = pg8::Gemm{XB, (const bf16_t*)(wl + LW_GU1), M, NGU, DM, 0}; E.kind = EPI_SWIGLU; break;
        case 8: g = pg8::Gemm{XB, (const bf16_t*)(wl + LW_GU2), M, NGU, DM, 0}; E.kind = EPI_SWIGLU; break;
        case 1: g = pg8::Gemm{HID, (const bf16_t*)(wl + LW_D1), M, DM, DFF, 1}; E.kind = EPI_RESID; E.base = l == 0 ? ka->in[0] : (const float*)ka->out; E.alpha = 0.5f; break;
        case 9: g = pg8::Gemm{HID, (const bf16_t*)(wl + LW_D2), M, DM, DFF, 1}; E.kind = EPI_RESID; E.base = ka->out; E.alpha = 0.5f; break;
        case 7: g = pg8::Gemm{(const bf16_t*)(ws + WS_U + U_MIX), (const bf16_t*)(wl + LW_OUT), M, DM, DM, 0}; E.kind = EPI_RESID; E.base = ka->out; E.alpha = 1.0f; break;
        case 2: g = pg8::Gemm{XB, (const bf16_t*)(wl + LW_IN), M, split_ok ? NIN - 256 : NIN, DM, 0}; E.kind = EPI_WIN; E.fbias = ka->in[13] + l * 8; break;
        case 3:
            if (split_ok && cb < 64) { g = pg8::Gemm{XB, (const bf16_t*)(wl + LW_IN) + (size_t)(NIN - 256) * DM, M, 256, DM, 0}; E.kind = EPI_WIN; E.fbias = ka->in[13] + l * 8; E.pn_off = 12; sub_g = 64; }
            else { g = pg8::Gemm{(const bf16_t*)(ws + WS_U + U_CQ), (const bf16_t*)(wl + LW_QB), M, 1536, 512, 0}; E.kind = EPI_QB; if (split_ok) { sub_g = gridDim.x - 64; sub_c = cb - 64; } }
            break;
        default:
            if (split_ok && cb < 64) continue;
            g = pg8::Gemm{(const bf16_t*)(ws + WS_U + U_CKV), (const bf16_t*)(wl + LW_KV), M, 2048, 256, 0}; E.kind = EPI_KVB; if (split_ok) { sub_g = gridDim.x - 64; sub_c = cb - 64; }
            break;
        }
        pg8::StaticOrder S; S.init(g.M, g.N, sub_g, sub_c);
        pg8::gemm_phase<EpiAny, pg8::StaticOrder, true, true>(lds, g, S, E);
#endif
    }
#if defined(PROBE_SYNCS)
    for (int i = 0; i < PROBE_SYNCS; ++i) grid.sync();
#endif
}

#ifndef MK_PER_PHASE
#define MK_PER_PHASE 0
#endif
extern "C" void kernel_launch(void* const* d_in, const int* in_sizes, int n_in, void* d_out, int out_size, void* d_ws, size_t ws_size, hipStream_t stream) {
    static int grid = 0;
    if (grid == 0) {
        if (n_in != 20 || out_size != M * DM || ws_size < WS_END) { fprintf(stderr, "kernel_launch: unexpected shapes (n_in %d out %d ws %zu need %zu)\n", n_in, out_size, ws_size, (size_t)WS_END); grid = -1; return; }
        int dev = 0, cus = 0, per_cu = 0;
        hipGetDevice(&dev); hipDeviceGetAttribute(&cus, hipDeviceAttributeMultiprocessorCount, dev);
        if (hipFuncSetAttribute((const void*)mega_fwd, hipFuncAttributeMaxDynamicSharedMemorySize, LDS_BYTES) != hipSuccess) { fprintf(stderr, "kernel_launch: hipFuncSetAttribute failed\n"); grid = -1; return; }
        hipOccupancyMaxActiveBlocksPerMultiprocessor(&per_cu, (const void*)mega_fwd, 512, LDS_BYTES);
        if (per_cu < 1) per_cu = 1;
        grid = cus * per_cu;
    }
    if (grid < 0) return;
    Args a{};
    for (int i = 0; i < 20; ++i) a.in[i] = (const float*)d_in[i];
    a.out = (float*)d_out; a.ws = (unsigned char*)d_ws;
#if MK_PER_PHASE
    for (int ph = 0; ph < N_STEPS; ++ph) { a.ph_lo = ph; a.ph_hi = ph + 1; hipLaunchKernelGGL(mega_fwd, dim3(grid), dim3(512), LDS_BYTES, stream, a); }
#else
    a.ph_lo = 0; a.ph_hi = N_STEPS;
    void* args[] = {&a};
    hipError_t e = hipLaunchCooperativeKernel((const void*)mega_fwd, dim3(grid), dim3(512), args, LDS_BYTES, stream);
    if (e != hipSuccess) fprintf(stderr, "cooperative launch failed: %s (grid %d)\n", hipGetErrorString(e), grid);
#endif
}
```
